# Optimizing an MI355X kernel written in HIP

```python
import jax, jax.numpy as jnp
from jax import lax
import numpy as np

D_MODEL = 1024
BATCH = 4
SEQ = 8192
DEPTH = 2

HEAD_DIM = 64
GROUP_WIDTH = D_MODEL // 2
GROUP_HEADS = GROUP_WIDTH // HEAD_DIM
RW_HEADS = GROUP_HEADS
RW_DIM = GROUP_WIDTH
DECAY_LORA = 64
AAA_LORA = 64
GATE_LORA = 128
RW_GN_EPS = 64e-5
MLA_HEADS = GROUP_HEADS
MLA_NOPE = HEAD_DIM
MLA_ROPE = HEAD_DIM // 2
MLA_V = HEAD_DIM
MLA_Q_RANK = D_MODEL // 4
MLA_KV_RANK = D_MODEL // 8
FOX_HEADS = GROUP_HEADS
FOX_DIM = GROUP_WIDTH
MOBA_HEADS = GROUP_HEADS
MOBA_DIM = GROUP_WIDTH
MOBA_BLOCK = 256
MOBA_TOPK = 3
MOBA_Q_CHUNK = 32
Q_BLOCK = 128
ROPE_THETA = 10000.0
NORM_EPS = 1e-6
D_FF = 256 * ((8 * D_MODEL // 3 + 255) // 256)
N_EXPERTS = 8
TOP_K = 2
D_EXPERT = 7 * D_MODEL // 2

RW_SIZES = (RW_DIM, RW_DIM, RW_DIM, DECAY_LORA, AAA_LORA, GATE_LORA)
RW_COLS = sum(RW_SIZES)
MLA_SIZES = (MLA_Q_RANK, MLA_KV_RANK, MLA_ROPE)
IN0_COLS = RW_COLS + sum(MLA_SIZES)
FOX_SIZES = (FOX_DIM, FOX_DIM, FOX_DIM, FOX_HEADS)
FOX_COLS = sum(FOX_SIZES)
MOBA_SIZES = (MOBA_DIM, MOBA_DIM, MOBA_DIM)
IN1_COLS = FOX_COLS + sum(MOBA_SIZES)
MIX0_OUT = RW_DIM + MLA_HEADS * MLA_V
MIX1_OUT = FOX_DIM + MOBA_DIM

kernel_name = 'hybrid_rwkv7_mla_fox_moba_moe'


def split_cols(t, sizes):
    return jnp.split(t, [int(i) for i in np.cumsum(sizes)[:-1]], axis=-1)


def to_heads(t, n_heads):
    b, s, _ = t.shape
    return t.reshape(b, s, n_heads, -1)


def rmsnorm(x, g, eps=NORM_EPS):
    xf = x.astype(jnp.float32)
    xf = xf * lax.rsqrt(jnp.mean(xf * xf, axis=-1, keepdims=True) + eps)
    return (xf * g.astype(jnp.float32)).astype(x.dtype)


def rope_tables(seq_len, dim):
    inv_freq = ROPE_THETA ** (-jnp.arange(0, dim, 2, dtype=jnp.float32) / dim)
    ang = jnp.arange(seq_len, dtype=jnp.float32)[:, None] * inv_freq[None, :]
    return jnp.cos(ang), jnp.sin(ang)


def apply_rope(x, cos_r, sin_r):
    xf = x.astype(jnp.float32)
    x1, x2 = jnp.split(xf, 2, axis=-1)
    c, s = cos_r[:, None, :], sin_r[:, None, :]
    return jnp.concatenate([x1 * c - x2 * s, x2 * c + x1 * s], axis=-1).astype(x.dtype)


def swiglu(t, w_gate, w_up, w_down):
    return (jax.nn.silu(t @ w_gate) * (t @ w_up)) @ w_down


def block_causal_attention(q, k, v, scale, log_decay_cum=None):
    b, h, s, _ = q.shape
    k_pos = jnp.arange(s)

    def one_block(i):
        start = i * Q_BLOCK
        qb = lax.dynamic_slice_in_dim(q, start, Q_BLOCK, axis=2)
        logits = jnp.einsum('bhqd,bhkd->bhqk', qb, k).astype(jnp.float32) * scale
        q_pos = start + jnp.arange(Q_BLOCK)
        if log_decay_cum is not None:
            dq = lax.dynamic_slice_in_dim(log_decay_cum, start, Q_BLOCK, axis=2)
            logits = logits + dq[..., :, None] - log_decay_cum[..., None, :]
        logits = jnp.where(k_pos[None, :] <= q_pos[:, None], logits, -jnp.inf)
        p = jax.nn.softmax(logits, axis=-1).astype(v.dtype)
        return jnp.einsum('bhqk,bhkd->bhqd', p, v)

    out = lax.map(one_block, jnp.arange(s // Q_BLOCK))
    return out.transpose(1, 2, 0, 3, 4).reshape(b, h, s, -1)


def rwkv7_time_mix(r, k, v, w_down, a_down, g_down, w0, w2, a0, a2, g2,
                   k_k, k_a, r_k, lnx_g, lnx_b):
    out_dtype = r.dtype
    f32 = jnp.float32
    r, k, v, w_down, a_down, g_down = (t.astype(f32) for t in (r, k, v, w_down, a_down, g_down))
    b, s, c = r.shape
    h, n = RW_HEADS, HEAD_DIM
    log_w = -jax.nn.softplus(-(w0 + jnp.tanh(w_down) @ w2)) - 0.5
    decay = jnp.exp(-jnp.exp(log_w))
    a = jax.nn.sigmoid(a0 + a_down @ a2)
    g = jax.nn.sigmoid(g_down) @ g2
    kk = (k * k_k).reshape(b, s, h, n)
    kk = kk / jnp.maximum(jnp.linalg.norm(kk, axis=-1, keepdims=True), 1e-12)
    k = k * (1.0 + (a - 1.0) * k_a)
    r_h, w_h, k_h, v_h, a_h = (t.reshape(b, s, h, n) for t in (r, decay, k, v, a))
    b_h = kk * a_h
    xs = tuple(jnp.moveaxis(t, 1, 0) for t in (r_h, w_h, k_h, v_h, kk, b_h))

    def step(state, inp):
        r_t, w_t, k_t, v_t, kk_t, b_t = inp
        sa = jnp.einsum('bhvk,bhk->bhv', state, -kk_t)
        state = (state * w_t[:, :, None, :] + sa[..., None] * b_t[:, :, None, :]
                 + v_t[..., None] * k_t[:, :, None, :])
        return state, jnp.einsum('bhvk,bhk->bhv', state, r_t)

    state0 = jnp.zeros((b, h, n, n), f32)
    _, y = lax.scan(step, state0, xs)
    y = jnp.moveaxis(y, 0, 1)
    mu = jnp.mean(y, axis=-1, keepdims=True)
    var = jnp.mean(jnp.square(y - mu), axis=-1, keepdims=True)
    y = ((y - mu) * lax.rsqrt(var + RW_GN_EPS)).reshape(b, s, c) * lnx_g + lnx_b
    bonus = jnp.sum(r_h * k_h * r_k, axis=-1, keepdims=True) * v_h
    y = (y + bonus.reshape(b, s, c)) * g
    return y.astype(out_dtype)


def mla_attention(q_lat, kv_lat, k_rope, q_norm, w_uq, kv_norm, w_ukv, cos_r, sin_r):
    b, s, _ = q_lat.shape
    h = MLA_HEADS
    q = to_heads(rmsnorm(q_lat, q_norm) @ w_uq, h)
    q_nope, q_pe = q[..., :MLA_NOPE], apply_rope(q[..., MLA_NOPE:], cos_r, sin_r)
    kv = to_heads(rmsnorm(kv_lat, kv_norm) @ w_ukv, h)
    k_nope, v = kv[..., :MLA_NOPE], kv[..., MLA_NOPE:]
    k_pe = apply_rope(k_rope[:, :, None, :], cos_r, sin_r)
    q = jnp.concatenate([q_nope, q_pe], axis=-1)
    k = jnp.concatenate([k_nope, jnp.broadcast_to(k_pe, (b, s, h, MLA_ROPE))], axis=-1)
    out = block_causal_attention(q.transpose(0, 2, 1, 3), k.transpose(0, 2, 1, 3),
                                 v.transpose(0, 2, 1, 3), (MLA_NOPE + MLA_ROPE) ** -0.5)
    return out.transpose(0, 2, 1, 3).reshape(b, s, h * MLA_V)


def forgetting_attention(q, k, v, f_logit, b_f):
    b, s, _ = q.shape
    h = FOX_HEADS
    log_f = jax.nn.log_sigmoid(f_logit.astype(jnp.float32) + b_f.astype(jnp.float32))
    d_cum = jnp.cumsum(log_f, axis=1).transpose(0, 2, 1)
    qh, kh, vh = (to_heads(t, h).transpose(0, 2, 1, 3) for t in (q, k, v))
    out = block_causal_attention(qh, kh, vh, HEAD_DIM ** -0.5, d_cum)
    return out.transpose(0, 2, 1, 3).reshape(b, s, h * HEAD_DIM)


def moba_attention(q, k, v, cos_r, sin_r):
    b, s, _ = q.shape
    h, d = MOBA_HEADS, HEAD_DIM
    qh = apply_rope(to_heads(q, h), cos_r, sin_r).transpose(0, 2, 1, 3)
    kh = apply_rope(to_heads(k, h), cos_r, sin_r).transpose(0, 2, 1, 3)
    vh = to_heads(v, h).transpose(0, 2, 1, 3)
    nb = -(-s // MOBA_BLOCK)
    pad = nb * MOBA_BLOCK - s
    kp = jnp.pad(kh, ((0, 0), (0, 0), (0, pad), (0, 0)))
    vp = jnp.pad(vh, ((0, 0), (0, 0), (0, pad), (0, 0)))
    k_blocks = kp.reshape(b, h, nb, MOBA_BLOCK, d)
    v_blocks = vp.reshape(b, h, nb, MOBA_BLOCK, d)
    k_mean = jnp.mean(k_blocks.astype(jnp.float32), axis=3).astype(kh.dtype)
    n_sel = min(MOBA_TOPK, nb)
    n_sel_keys = n_sel * MOBA_BLOCK
    scale = d ** -0.5
    b_idx = jnp.arange(b)[:, None, None, None]
    h_idx = jnp.arange(h)[None, :, None, None]
    blk_ids = jnp.arange(nb)
    offs = jnp.arange(MOBA_BLOCK)

    def one_chunk(i):
        start = i * MOBA_Q_CHUNK
        qc = lax.dynamic_slice_in_dim(qh, start, MOBA_Q_CHUNK, axis=2)
        q_pos = start + jnp.arange(MOBA_Q_CHUNK)
        own = start // MOBA_BLOCK
        gate = jnp.einsum('bhqd,bhnd->bhqn', qc, k_mean).astype(jnp.float32)
        gate = jnp.where(blk_ids < own, gate, -jnp.inf)
        _, sel = lax.top_k(gate, n_sel)
        sel_valid = sel < own
        k_sel = k_blocks[b_idx, h_idx, sel]
        v_sel = v_blocks[b_idx, h_idx, sel]
        s_sel = jnp.einsum('bhqd,bhqjld->bhqjl', qc, k_sel).astype(jnp.float32) * scale
        s_sel = jnp.where(sel_valid[..., None], s_sel, -jnp.inf)
        k_own = lax.dynamic_slice_in_dim(kp, own * MOBA_BLOCK, MOBA_BLOCK, axis=2)
        v_own = lax.dynamic_slice_in_dim(vp, own * MOBA_BLOCK, MOBA_BLOCK, axis=2)
        s_own = jnp.einsum('bhqd,bhld->bhql', qc, k_own).astype(jnp.float32) * scale
        s_own = jnp.where((own * MOBA_BLOCK + offs)[None, :] <= q_pos[:, None], s_own, -jnp.inf)
        logits = jnp.concatenate([s_sel.reshape(b, h, MOBA_Q_CHUNK, n_sel_keys), s_own], axis=-1)
        p = jax.nn.softmax(logits, axis=-1).astype(vh.dtype)
        p_sel = p[..., :n_sel_keys].reshape(b, h, MOBA_Q_CHUNK, n_sel, MOBA_BLOCK)
        p_own = p[..., n_sel_keys:]
        return (jnp.einsum('bhqjl,bhqjld->bhqd', p_sel, v_sel)
                + jnp.einsum('bhql,bhld->bhqd', p_own, v_own))

    out = lax.map(one_chunk, jnp.arange(s // MOBA_Q_CHUNK))
    out = out.transpose(1, 2, 0, 3, 4).reshape(b, h, s, d)
    return out.transpose(0, 2, 1, 3).reshape(b, s, h * d)


def moe_swiglu(t, router, w_gate, w_up, w_down):
    logits = (t @ router).astype(jnp.float32)
    top_logits, top_idx = lax.top_k(logits, TOP_K)
    gates = jax.nn.softmax(top_logits, axis=-1)
    combine = jnp.sum(jax.nn.one_hot(top_idx, N_EXPERTS, dtype=jnp.float32) * gates[..., None], axis=1)
    out = jnp.zeros_like(t)
    for e in range(N_EXPERTS):
        out = out + combine[:, e:e + 1].astype(t.dtype) * swiglu(t, w_gate[e], w_up[e], w_down[e])
    return out


def even_layer(h, norm_mix, w_in, shift_mu, rw_w0, rw_w2, rw_a0, rw_a2, rw_g2, rw_kk, rw_ka,
               rw_rk, rw_lnx_g, rw_lnx_b, mla_qnorm, mla_wuq, mla_kvnorm, mla_wukv, w_out,
               norm_ffn, ffn_wg, ffn_wu, ffn_wd, cos_r, sin_r):
    u = rmsnorm(h, norm_mix)
    proj = u @ w_in
    rw_cols, mla_cols = proj[..., :RW_COLS], proj[..., RW_COLS:]
    rw_prev = jnp.pad(rw_cols[:, :-1], ((0, 0), (1, 0), (0, 0)))
    rw_cols = rw_cols + shift_mu * (rw_prev - rw_cols)
    y_a = rwkv7_time_mix(*split_cols(rw_cols, RW_SIZES), rw_w0, rw_w2, rw_a0, rw_a2, rw_g2,
                         rw_kk, rw_ka, rw_rk, rw_lnx_g, rw_lnx_b)
    y_b = mla_attention(*split_cols(mla_cols, MLA_SIZES), mla_qnorm, mla_wuq, mla_kvnorm,
                        mla_wukv, cos_r, sin_r)
    h = h + jnp.concatenate([y_a, y_b], axis=-1) @ w_out
    return h + swiglu(rmsnorm(h, norm_ffn), ffn_wg, ffn_wu, ffn_wd)


def odd_layer(h, norm_mix, w_in, fox_bf, w_out, norm_ffn, router, moe_wg, moe_wu, moe_wd,
              cos_r, sin_r):
    b, s, d = h.shape
    u = rmsnorm(h, norm_mix)
    proj = u @ w_in
    fox_cols, moba_cols = proj[..., :FOX_COLS], proj[..., FOX_COLS:]
    y_c = forgetting_attention(*split_cols(fox_cols, FOX_SIZES), fox_bf)
    y_d = moba_attention(*split_cols(moba_cols, MOBA_SIZES), cos_r, sin_r)
    h = h + jnp.concatenate([y_c, y_d], axis=-1) @ w_out
    t = rmsnorm(h, norm_ffn).reshape(b * s, d)
    return h + moe_swiglu(t, router, moe_wg, moe_wu, moe_wd).reshape(b, s, d)


def setup_inputs(seed: int = 0) -> dict:
    key = jax.random.key(seed)
    ks = iter(jax.random.split(key, 40))
    D = D_MODEL

    def nrm(shape, scale):
        return scale * jax.random.normal(next(ks), shape, jnp.float32)

    def gain(n):
        return 1.0 + nrm((n,), 0.05)

    return {
        'x': nrm((BATCH, SEQ, D), 1.0),
        'norm_mix_0': gain(D),
        'w_in_0': nrm((D, IN0_COLS), D ** -0.5),
        'shift_mu_0': jax.random.uniform(next(ks), (RW_COLS,), jnp.float32, 0.2, 0.8),
        'rw_w0_0': jax.random.uniform(next(ks), (RW_DIM,), jnp.float32, -6.0, -1.0),
        'rw_w2_0': nrm((DECAY_LORA, RW_DIM), DECAY_LORA ** -0.5),
        'rw_a0_0': nrm((RW_DIM,), 0.1),
        'rw_a2_0': nrm((AAA_LORA, RW_DIM), AAA_LORA ** -0.5),
        'rw_g2_0': nrm((GATE_LORA, RW_DIM), GATE_LORA ** -0.5),
        'rw_kk_0': 0.85 + nrm((RW_DIM,), 0.05),
        'rw_ka_0': 1.0 + nrm((RW_DIM,), 0.05),
        'rw_rk_0': nrm((RW_HEADS, HEAD_DIM), 0.1),
        'rw_lnx_g_0': gain(RW_DIM),
        'rw_lnx_b_0': nrm((RW_DIM,), 0.02),
        'mla_qnorm_0': gain(MLA_Q_RANK),
        'mla_wuq_0': nrm((MLA_Q_RANK, MLA_HEADS * (MLA_NOPE + MLA_ROPE)), MLA_Q_RANK ** -0.5),
        'mla_kvnorm_0': gain(MLA_KV_RANK),
        'mla_wukv_0': nrm((MLA_KV_RANK, MLA_HEADS * (MLA_NOPE + MLA_V)), MLA_KV_RANK ** -0.5),
        'w_out_0': nrm((MIX0_OUT, D), MIX0_OUT ** -0.5),
        'norm_ffn_0': gain(D),
        'ffn_wg_0': nrm((D, D_FF), D ** -0.5),
        'ffn_wu_0': nrm((D, D_FF), D ** -0.5),
        'ffn_wd_0': nrm((D_FF, D), D_FF ** -0.5),
        'norm_mix_1': gain(D),
        'w_in_1': nrm((D, IN1_COLS), D ** -0.5),
        'fox_bf_1': 3.0 + nrm((FOX_HEADS,), 0.5),
        'w_out_1': nrm((MIX1_OUT, D), MIX1_OUT ** -0.5),
        'norm_ffn_1': gain(D),
        'router_1': nrm((D, N_EXPERTS), D ** -0.5),
        'moe_wg_1': nrm((N_EXPERTS, D, D_EXPERT), D ** -0.5),
        'moe_wu_1': nrm((N_EXPERTS, D, D_EXPERT), D ** -0.5),
        'moe_wd_1': nrm((N_EXPERTS, D_EXPERT, D), D_EXPERT ** -0.5),
        'final_norm': gain(D),
    }


def reference(x, norm_mix_0, w_in_0, shift_mu_0, rw_w0_0, rw_w2_0, rw_a0_0, rw_a2_0, rw_g2_0,
              rw_kk_0, rw_ka_0, rw_rk_0, rw_lnx_g_0, rw_lnx_b_0, mla_qnorm_0, mla_wuq_0,
              mla_kvnorm_0, mla_wukv_0, w_out_0, norm_ffn_0, ffn_wg_0, ffn_wu_0, ffn_wd_0,
              norm_mix_1, w_in_1, fox_bf_1, w_out_1, norm_ffn_1, router_1, moe_wg_1, moe_wu_1,
              moe_wd_1, final_norm):
    seq_len = x.shape[1]
    rope_mla = rope_tables(seq_len, MLA_ROPE)
    rope_full = rope_tables(seq_len, HEAD_DIM)
    layer_params = (
        (norm_mix_0, w_in_0, shift_mu_0, rw_w0_0, rw_w2_0, rw_a0_0, rw_a2_0, rw_g2_0, rw_kk_0,
         rw_ka_0, rw_rk_0, rw_lnx_g_0, rw_lnx_b_0, mla_qnorm_0, mla_wuq_0, mla_kvnorm_0,
         mla_wukv_0, w_out_0, norm_ffn_0, ffn_wg_0, ffn_wu_0, ffn_wd_0),
        (norm_mix_1, w_in_1, fox_bf_1, w_out_1, norm_ffn_1, router_1, moe_wg_1, moe_wu_1,
         moe_wd_1),
    )
    h = x
    for layer in range(DEPTH):
        if layer % 2 == 0:
            h = even_layer(h, *layer_params[layer], *rope_mla)
        else:
            h = odd_layer(h, *layer_params[layer], *rope_full)
    return rmsnorm(h, final_norm)
```

```cpp
#include <hip/hip_runtime.h>
#include <cstdio>
#include <cstdint>
#include <cmath>
namespace pg8 {
#define PG8_LAS __attribute__((address_space(3)))
typedef unsigned short bf16_t;
typedef short bf16x8 __attribute__((ext_vector_type(8)));
typedef float f32x4 __attribute__((ext_vector_type(4)));
typedef unsigned u32x4 __attribute__((ext_vector_type(4)));
constexpr int BM = 256, BK = 64, HALF = 128, HTB = HALF * BK * 2  , STAGE_BYTES = 8 * HTB, NXCD = 8, WGM = 8;

__host__ __device__ __forceinline__ int lds_byte(int r, int c) { const int st = (r >> 4) * 2 + (c >> 5), rr = r & 15, cc = c & 31, ob = rr * 64 + cc * 2; return st * 1024 + (ob ^ (((ob >> 9) & 1) << 5)); }
__host__ __device__ __forceinline__ void stage_rc(int b, int& R, int& C) { const int st = b / 1024, sb = b % 1024, swz = sb ^ (((sb >> 9) & 1) << 5); R = (st >> 1) * 16 + swz / 64; C = (st & 1) * 32 + (swz % 64) / 2; }
__host__ __device__ __forceinline__ int perm32(int rho) { const int n = rho >> 4, i = rho & 15; return 8 * (i >> 2) + 4 * n + (i & 3); }

struct Unit { int pm, pn, om, on, koff, os; };
struct Gemm { const bf16_t* A; const bf16_t* Bt; int M, N, K, ld; };

struct StaticOrder {
    int nM, nN, nwg, G, c;
    __host__ __device__ void init(int M, int N, int G_, int c_) { nM = M / BM; nN = N / BM; nwg = nM * nN; G = G_; c = c_; }
    __host__ __device__ bool next(int i, Unit& u) const {
        const long L = (long)i * G + c; if (L >= nwg) return false;
        int wgid = (int)L; { const int q = nwg / NXCD, r = nwg % NXCD, xcd = wgid % NXCD, off = wgid / NXCD; wgid = (xcd < r ? xcd * (q + 1) : r * (q + 1) + (xcd - r) * q) + off; }
        const int nig = WGM * nN, gid = wgid / nig, fm = gid * WGM, gsz = (nM - fm) < WGM ? (nM - fm) : WGM;
        u.pm = fm + ((wgid % nig) % gsz); u.pn = (wgid % nig) / gsz; u.om = u.pm; u.on = u.pn; u.koff = 0; u.os = 0; return true;
    }
    __device__ __forceinline__ void a_ready(const Unit&) const {}
    __device__ __forceinline__ void done(const Unit&) const {}
};

__device__ __forceinline__ unsigned cvt_pk_bf16(float lo, float hi) { unsigned r; asm volatile("v_cvt_pk_bf16_f32 %0, %1, %2" : "=v"(r) : "v"(lo), "v"(hi)); return r; }
typedef float f32x2 __attribute__((ext_vector_type(2)));
__device__ __forceinline__ float sigmoid_f(float x) { return __builtin_amdgcn_rcpf(1.0f + __expf(-x)); }
__device__ __forceinline__ f32x2 swiglu2(f32x2 g, f32x2 u, float k0, float k1, float k2) {
    const f32x2 t = __builtin_elementwise_fma(g, (f32x2){k0, k0}, (f32x2){k1, k1}); f32x2 r; r[0] = __builtin_amdgcn_rcpf(k2 + __builtin_amdgcn_exp2f(t[0])); r[1] = __builtin_amdgcn_rcpf(k2 + __builtin_amdgcn_exp2f(t[1]));
    return (g * u) * r;
}
#define PG8_LO2(v) __builtin_shufflevector(v, v, 0, 1)
#define PG8_HI2(v) __builtin_shufflevector(v, v, 2, 3)
struct EpiStore {
    static constexpr bool PERM = true, AFTER_DRAIN = false;
    bf16_t* O; int ldc; size_t slab;
    __device__ __forceinline__ void operator()(const f32x4 (&acc)[2][2][4][2], const Unit& u, int wr, int wc, int fr, int fq) const {
        const int row0 = u.om * BM + wr * 64 + fr, col0 = u.on * BM + wc * 32 + 8 * fq;
#pragma unroll
        for (int ai = 0; ai < 2; ++ai)
#pragma unroll
            for (int m = 0; m < 4; ++m) { bf16_t* rowp = O + (size_t)u.os * slab + (size_t)(row0 + ai * HALF + m * 16) * ldc + col0;
#pragma unroll
                for (int bj = 0; bj < 2; ++bj) { const f32x4 v0 = acc[ai][bj][m][0], v1 = acc[ai][bj][m][1];
                    u32x4 w; w.x = cvt_pk_bf16(v0[0], v0[1]); w.y = cvt_pk_bf16(v0[2], v0[3]); w.z = cvt_pk_bf16(v1[0], v1[1]); w.w = cvt_pk_bf16(v1[2], v1[3]);
                    *(u32x4*)(rowp + bj * HALF) = w; } }
    }
};
struct EpiLora {
    static constexpr bool PERM = true, AFTER_DRAIN = false;
    bf16_t* EW; const float* w0; const float* a0;
    __device__ __forceinline__ void operator()(const f32x4 (&acc)[2][2][4][2], const Unit& u, int wr, int wc, int fr, int fq) const {
        const int kind = u.on >> 1; bf16_t* O = EW + (size_t)kind * (16u << 20); const float* bias = kind == 0 ? w0 : a0;
        const int row0 = u.om * BM + wr * 64 + fr, col0 = (u.on & 1) * BM + wc * 32 + 8 * fq;
        f32x4 bq[2][2];
#pragma unroll
        for (int bj = 0; bj < 2; ++bj) { bq[bj][0] = *(const f32x4*)(bias + col0 + bj * HALF); bq[bj][1] = *(const f32x4*)(bias + col0 + bj * HALF + 4); }
#pragma unroll
        for (int ai = 0; ai < 2; ++ai)
#pragma unroll
            for (int m = 0; m < 4; ++m) { bf16_t* rowp = O + (size_t)(row0 + ai * HALF + m * 16) * 512 + col0;
#pragma unroll
                for (int bj = 0; bj < 2; ++bj) { f32x4 v0 = acc[ai][bj][m][0], v1 = acc[ai][bj][m][1];
                    if (kind < 2) { const float sc = kind == 0 ? 0.60653066f : 1.0f; const f32x4 b0 = bq[bj][0], b1 = bq[bj][1];
#pragma unroll
                        for (int e = 0; e < 4; ++e) { v0[e] = sc * sigmoid_f(v0[e] + b0[e]); v1[e] = sc * sigmoid_f(v1[e] + b1[e]); } }
                    u32x4 w; w.x = cvt_pk_bf16(v0[0], v0[1]); w.y = cvt_pk_bf16(v0[2], v0[3]); w.z = cvt_pk_bf16(v1[0], v1[1]); w.w = cvt_pk_bf16(v1[2], v1[3]);
                    *(u32x4*)(rowp + bj * HALF) = w; asm volatile("" ::: "memory"); } }
    }
};
struct EpiResid {
    static constexpr bool PERM = true, AFTER_DRAIN = false;
    const float* base; float* out; int ldc; bf16_t* xn; float* ssq;
    __device__ __forceinline__ void operator()(const f32x4 (&acc)[2][2][4][2], const Unit& u, int wr, int wc, int fr, int fq) const {
        const int row0 = u.om * BM + wr * 64 + fr, col0 = u.on * BM + wc * 32 + 8 * fq;
#pragma unroll
        for (int ai = 0; ai < 2; ++ai)
#pragma unroll
            for (int m = 0; m < 4; ++m) { const int row = row0 + ai * HALF + m * 16; const size_t off = (size_t)row * ldc + col0; float ss = 0.f;
#pragma unroll
                for (int bj = 0; bj < 2; ++bj) { const f32x4 b0 = *(const f32x4*)(base + off + bj * HALF), b1 = *(const f32x4*)(base + off + bj * HALF + 4);
                    const f32x4 o0 = b0 + acc[ai][bj][m][0], o1 = b1 + acc[ai][bj][m][1];
                    *(f32x4*)(out + off + bj * HALF) = o0; *(f32x4*)(out + off + bj * HALF + 4) = o1;
                    if (xn) { u32x4 w; w.x = cvt_pk_bf16(o0[0], o0[1]); w.y = cvt_pk_bf16(o0[2], o0[3]); w.z = cvt_pk_bf16(o1[0], o1[1]); w.w = cvt_pk_bf16(o1[2], o1[3]); *(u32x4*)(xn + off + bj * HALF) = w;
                        ss += (o0[0] * o0[0] + o0[1] * o0[1]) + (o0[2] * o0[2] + o0[3] * o0[3]) + (o1[0] * o1[0] + o1[1] * o1[1]) + (o1[2] * o1[2] + o1[3] * o1[3]); } }
                if (xn) { ss += __shfl_xor(ss, 16); ss += __shfl_xor(ss, 32); if (fq == 0) ssq[(size_t)row * 16 + u.on * 4 + wc] = ss; } }
    }
};
template <bool IN_BF, bool OUT_BF> struct EpiResidT {
    static constexpr bool PERM = true, AFTER_DRAIN = false;
    const void* base; void* out; static constexpr int ldc = 1024;
    __device__ __forceinline__ void operator()(const f32x4 (&acc)[2][2][4][2], const Unit& u, int wr, int wc, int fr, int fq) const {
        const int row0 = u.om * BM + wr * 64 + fr, col0 = u.on * BM + wc * 32 + 8 * fq;
#pragma unroll
        for (int ai = 0; ai < 2; ++ai) { f32x4 bb[4][2][2];
#pragma unroll
            for (int m = 0; m < 4; ++m) { const size_t off = (size_t)(row0 + ai * HALF + m * 16) * ldc + col0;
#pragma unroll
                for (int bj = 0; bj < 2; ++bj) {
                    if constexpr (IN_BF) { const u32x4 w = *(const u32x4*)((const bf16_t*)base + off + bj * HALF);
                        bb[m][bj][0] = (f32x4){__builtin_bit_cast(float, w.x << 16), __builtin_bit_cast(float, w.x & 0xffff0000u), __builtin_bit_cast(float, w.y << 16), __builtin_bit_cast(float, w.y & 0xffff0000u)};
                        bb[m][bj][1] = (f32x4){__builtin_bit_cast(float, w.z << 16), __builtin_bit_cast(float, w.z & 0xffff0000u), __builtin_bit_cast(float, w.w << 16), __builtin_bit_cast(float, w.w & 0xffff0000u)}; }
                    else { bb[m][bj][0] = *(const f32x4*)((const float*)base + off + bj * HALF); bb[m][bj][1] = *(const f32x4*)((const float*)base + off + bj * HALF + 4); } } }
#pragma unroll
            for (int m = 0; m < 4; ++m) { const size_t off = (size_t)(row0 + ai * HALF + m * 16) * ldc + col0;
#pragma unroll
                for (int bj = 0; bj < 2; ++bj) { const f32x4 o0 = bb[m][bj][0] + acc[ai][bj][m][0], o1 = bb[m][bj][1] + acc[ai][bj][m][1];
                    if constexpr (OUT_BF) { u32x4 w; w.x = cvt_pk_bf16(o0[0], o0[1]); w.y = cvt_pk_bf16(o0[2], o0[3]); w.z = cvt_pk_bf16(o1[0], o1[1]); w.w = cvt_pk_bf16(o1[2], o1[3]); *(u32x4*)((bf16_t*)out + off + bj * HALF) = w; }
                    else { *(f32x4*)((float*)out + off + bj * HALF) = o0; *(f32x4*)((float*)out + off + bj * HALF + 4) = o1; } } } }
    }
};
struct EpiSwiGLU {
    static constexpr bool PERM = true, AFTER_DRAIN = false;
    bf16_t* O; int ldc; const float* ssq; float eps;
    __device__ __forceinline__ void operator()(const f32x4 (&acc)[2][2][4][2], const Unit& u, int wr, int wc, int fr, int fq) const {
        const int row0 = u.om * BM + wr * 64 + fr, col0 = u.on * HALF + wc * 32 + 8 * fq;
#pragma unroll
        for (int ai = 0; ai < 2; ++ai)
#pragma unroll
            for (int m = 0; m < 4; ++m) { const int row = row0 + ai * HALF + m * 16; bf16_t* rowp = O + (size_t)row * ldc + col0; float rs = 1.0f;
                if (ssq) { const f32x4* sp = (const f32x4*)(ssq + (size_t)row * 16); const f32x4 s0 = sp[0], s1 = sp[1], s2 = sp[2], s3 = sp[3];
                    const float t = ((s0[0] + s0[1]) + (s0[2] + s0[3])) + ((s1[0] + s1[1]) + (s1[2] + s1[3])) + ((s2[0] + s2[1]) + (s2[2] + s2[3])) + ((s3[0] + s3[1]) + (s3[2] + s3[3]));
                    rs = __builtin_amdgcn_rsqf(t * (1.0f / 1024.0f) + eps); }
                const float k0 = -1.44269504f * rs, k2 = 1.0f / (rs * rs), k1 = ssq ? __builtin_amdgcn_logf(k2) : 0.0f;
                const f32x2 ha = swiglu2(PG8_LO2(acc[ai][0][m][0]), PG8_LO2(acc[ai][1][m][0]), k0, k1, k2), hb = swiglu2(PG8_HI2(acc[ai][0][m][0]), PG8_HI2(acc[ai][1][m][0]), k0, k1, k2);
                const f32x2 hc = swiglu2(PG8_LO2(acc[ai][0][m][1]), PG8_LO2(acc[ai][1][m][1]), k0, k1, k2), hd = swiglu2(PG8_HI2(acc[ai][0][m][1]), PG8_HI2(acc[ai][1][m][1]), k0, k1, k2);
                u32x4 w; w.x = cvt_pk_bf16(ha[0], ha[1]); w.y = cvt_pk_bf16(hb[0], hb[1]); w.z = cvt_pk_bf16(hc[0], hc[1]); w.w = cvt_pk_bf16(hd[0], hd[1]);
                *(u32x4*)rowp = w; }
    }
};
constexpr float F8_SX = 16.0f, F8_SW1 = 256.0f, F8_SH = 8.0f, F8_SW2 = 512.0f;
__device__ __forceinline__ float sat8(float x) { return __builtin_amdgcn_fmed3f(x, -448.0f, 448.0f); }
__device__ __forceinline__ unsigned pk4_fp8(float a, float b, float c, float d) { int w = __builtin_amdgcn_cvt_pk_fp8_f32(sat8(a), sat8(b), 0, false); w = __builtin_amdgcn_cvt_pk_fp8_f32(sat8(c), sat8(d), w, true); return (unsigned)w; }
struct EpiSwiGLU8 {
    static constexpr bool PERM = true, AFTER_DRAIN = false;
    unsigned char* O; static constexpr int ldc = 3584; static constexpr float sin = 1.0f / (F8_SX * F8_SW1), sout = F8_SH;
    __device__ __forceinline__ void operator()(const f32x4 (&acc)[2][2][4][2], const Unit& u, int wr, int wc, int fr, int fq) const {
        const int row0 = u.om * BM + wr * 64 + fr, col0 = u.on * HALF + wc * 32 + 8 * fq;
#pragma unroll
        for (int ai = 0; ai < 2; ++ai)
#pragma unroll
            for (int m = 0; m < 4; ++m) { const int row = row0 + ai * HALF + m * 16; unsigned char* rowp = O + (size_t)row * ldc + col0;
                constexpr float c = sin * sin * sout, k0 = -1.44269504f * sin, k2 = 1.0f / c, k1 = 21.0f; static_assert(k2 == 2097152.0f, "k1 = log2(1 / c)");
                const f32x2 ha = swiglu2(PG8_LO2(acc[ai][0][m][0]), PG8_LO2(acc[ai][1][m][0]), k0, k1, k2), hb = swiglu2(PG8_HI2(acc[ai][0][m][0]), PG8_HI2(acc[ai][1][m][0]), k0, k1, k2);
                const f32x2 hc = swiglu2(PG8_LO2(acc[ai][0][m][1]), PG8_LO2(acc[ai][1][m][1]), k0, k1, k2), hd = swiglu2(PG8_HI2(acc[ai][0][m][1]), PG8_HI2(acc[ai][1][m][1]), k0, k1, k2);
                f32x2 w; unsigned w0 = pk4_fp8(ha[0], ha[1], hb[0], hb[1]), w1 = pk4_fp8(hc[0], hc[1], hd[0], hd[1]); w[0] = __builtin_bit_cast(float, w0); w[1] = __builtin_bit_cast(float, w1);
                *(f32x2*)rowp = w; }
    }
};
struct EpiStoreSc {
    static constexpr bool PERM = true, AFTER_DRAIN = false;
    bf16_t* O; size_t slab; static constexpr int ldc = 1024; static constexpr float sc = 1.0f / (F8_SH * F8_SW2);
    __device__ __forceinline__ void operator()(const f32x4 (&acc)[2][2][4][2], const Unit& u, int wr, int wc, int fr, int fq) const {
        const int row0 = u.om * BM + wr * 64 + fr, col0 = u.on * BM + wc * 32 + 8 * fq;
#pragma unroll
        for (int ai = 0; ai < 2; ++ai)
#pragma unroll
            for (int m = 0; m < 4; ++m) { bf16_t* rowp = O + (size_t)u.os * slab + (size_t)(row0 + ai * HALF + m * 16) * ldc + col0;
#pragma unroll
                for (int bj = 0; bj < 2; ++bj) { const f32x4 v0 = acc[ai][bj][m][0] * sc, v1 = acc[ai][bj][m][1] * sc;
                    u32x4 w; w.x = cvt_pk_bf16(v0[0], v0[1]); w.y = cvt_pk_bf16(v0[2], v0[3]); w.z = cvt_pk_bf16(v1[0], v1[1]); w.w = cvt_pk_bf16(v1[2], v1[3]);
                    *(u32x4*)(rowp + bj * HALF) = w; } }
    }
};
struct MoeOrder {
    const int* tile_e; int rt0, ntp, nbn, G, c; bool a_local;
    int lt0, nsplit, klen;
    __device__ __forceinline__ bool next(int i, Unit& u) const {
        const long L = (long)i * G + c; if (L >= (long)ntp * nbn * nsplit) return false;
        const int j = (int)(L % nsplit), q = (int)(L / nsplit), pn = q / ntp, lt = lt0 + q % ntp, rt = rt0 + lt; const int e = __builtin_amdgcn_readfirstlane(tile_e[rt]);
        u.pm = a_local ? lt : rt; u.pn = e * nbn + pn; u.om = a_local ? rt : lt; u.on = pn; u.koff = j * klen; u.os = j; return true;
    }
    __device__ __forceinline__ void a_ready(const Unit&) const {}
    __device__ __forceinline__ void done(const Unit&) const {}
};
struct MoeOrderAll {
    const int* tile_e; int nt, nbn, G, c;
    __device__ __forceinline__ bool next(int i, Unit& u) const {
        const int L = i * G + c; if (L >= nt * nbn) return false;
        const int nf = nt >> 6, per = 64 * nbn; int g = L / per; g = g < nf ? g : nf;
        const int r = L - g * per, gt = g < nf ? 64 : nt - 64 * nf; int pn = r / gt, rt = 64 * g + r % gt;
        if (G == 256 && g < nf && (nbn & 3) == 0) {
            const int rr = r >> 8, cc = r & 255, sl = cc >> 3; pn = 4 * rr + (sl >> 3); rt = 64 * g + 8 * (cc & 7) + (sl & 7); }
        const int e = __builtin_amdgcn_readfirstlane(tile_e[rt]);
        u.pm = rt; u.pn = e * nbn + pn; u.om = rt; u.on = pn; u.koff = 0; u.os = 0; return true;
    }
    __device__ __forceinline__ void a_ready(const Unit&) const {}
    __device__ __forceinline__ void done(const Unit&) const {}
};
typedef int i32x8 __attribute__((ext_vector_type(8)));
typedef int i32x4 __attribute__((ext_vector_type(4)));
__device__ __forceinline__ i32x8 cat8(bf16x8 a, bf16x8 b) { const i32x4 x = __builtin_bit_cast(i32x4, a), y = __builtin_bit_cast(i32x4, b); return __builtin_shufflevector(x, y, 0, 1, 2, 3, 4, 5, 6, 7); }
__device__ __forceinline__ void mfma_fp8(f32x4& c, const i32x8 a, const i32x8 b) { asm volatile("v_mfma_f32_16x16x128_f8f6f4 %0, %1, %2, %0" : "+v"(c) : "v"(a), "v"(b)); }
template <class Epi, class Sched, bool ALIGN_EPI = false, bool SP2 = false, bool F8 = false>
__device__ __forceinline__ void gemm_phase(PG8_LAS unsigned char* lds, const Gemm g, const Sched& S, const Epi& E) {
    int tid_ = threadIdx.x; asm volatile("" : "+v"(tid_));
    const int tid = tid_, wid = __builtin_amdgcn_readfirstlane(tid >> 6), lane = tid & 63, wr = wid >> 2, wc = wid & 3, fr = lane & 15, fq = lane >> 4;
    const int K = g.K, nt = K / BK, LD = g.ld ? g.ld : g.K;
    unsigned voffA[2], voffB[2];
#pragma unroll
    for (int i = 0; i < 2; ++i) { int R, C; stage_rc(tid * 16 + i * 8192, R, C); const int Rb = Epi::PERM ? ((R & ~31) + perm32(R & 31)) : R;
        voffA[i] = (unsigned)(R * LD + C) * 2u; voffB[i] = (unsigned)(Rb * LD + C) * 2u; }
    const size_t kstep = (size_t)(BK * 2);
    const size_t hstep = (size_t)HALF * LD * 2;
    const size_t tstep = 2 * hstep;
    const unsigned ldsw = (unsigned)wid * 1024u;
    const int aoff = lds_byte(wr * 64 + fr, fq * 8), boff = lds_byte(wc * 32 + fr, fq * 8);
#define PG8_SA(b, h) (((b) * 2 + (h)) * HTB)
#define PG8_SB(b, h) ((4 + (b) * 2 + (h)) * HTB)
#define PG8_STAGE(bufoff, gbase, voff) do { _Pragma("unroll") for (int _i = 0; _i < 2; ++_i) \
        __builtin_amdgcn_global_load_lds((const unsigned*)((const char*)(gbase) + (voff)[_i]), (PG8_LAS unsigned*)(lds + (bufoff) + ldsw + _i * 8192), 16, 0, 0); } while (0)
#define PG8_LDA(dst, b, h) do { _Pragma("unroll") for (int m = 0; m < 4; ++m) _Pragma("unroll") for (int k = 0; k < 2; ++k) dst[m][k] = *(const PG8_LAS bf16x8*)(lds + PG8_SA(b, h) + aoff + m * 2048 + k * 1024); } while (0)
#define PG8_LDB(dst, b, h) do { _Pragma("unroll") for (int n = 0; n < 2; ++n) _Pragma("unroll") for (int k = 0; k < 2; ++k) dst[n][k] = *(const PG8_LAS bf16x8*)(lds + PG8_SB(b, h) + boff + n * 2048 + k * 1024); } while (0)
#define PG8_MMA(ai, bj, At, Bt) do { __builtin_amdgcn_s_setprio(1); _Pragma("unroll") for (int m = 0; m < 4; ++m) _Pragma("unroll") for (int n = 0; n < 2; ++n) { \
        if constexpr (F8) mfma_fp8(acc[ai][bj][m][n], cat8(Bt[n][0], Bt[n][1]), cat8(At[m][0], At[m][1])); \
        else { _Pragma("unroll") for (int k = 0; k < 2; ++k) acc[ai][bj][m][n] = __builtin_amdgcn_mfma_f32_16x16x32_bf16(Bt[n][k], At[m][k], acc[ai][bj][m][n], 0, 0, 0); } } __builtin_amdgcn_s_setprio(0); } while (0)
#define PG8_WAIT_V(n) asm volatile("s_waitcnt vmcnt(" #n ")" ::: "memory")
#define PG8_WAIT_L(n) asm volatile("s_waitcnt lgkmcnt(" #n ")" ::: "memory")
#define PG8_BAR __builtin_amdgcn_s_barrier()
#define PG8_SCHED __builtin_amdgcn_sched_barrier(0)
    Unit cur, nxt; int ui = 0;
    if (!S.next(0, cur)) return;
    f32x4 acc[2][2][4][2];
#pragma unroll
    for (int a = 0; a < 2; ++a)
#pragma unroll
        for (int b = 0; b < 2; ++b)
#pragma unroll
            for (int m = 0; m < 4; ++m)
#pragma unroll
                for (int n = 0; n < 2; ++n) acc[a][b][m][n] = (f32x4){0.f, 0.f, 0.f, 0.f};
    bf16x8 At[4][2], B0[2][2], B1[2][2];
    const char* cA = (const char*)g.A + (size_t)cur.pm * tstep + (size_t)cur.koff * 2; const char* cB = (const char*)g.Bt + (size_t)cur.pn * tstep + (size_t)cur.koff * 2;
    S.a_ready(cur);
    if constexpr (SP2) {
        PG8_STAGE(PG8_SB(0, 0), cB, voffB); PG8_STAGE(PG8_SB(0, 1), cB + hstep, voffB); PG8_STAGE(PG8_SA(0, 0), cA, voffA); PG8_STAGE(PG8_SA(0, 1), cA + hstep, voffA);
        if (wr == 1) PG8_BAR;
        PG8_WAIT_V(2); PG8_BAR;
        PG8_STAGE(PG8_SB(1, 0), cB + kstep, voffB); PG8_STAGE(PG8_SA(1, 0), cA + kstep, voffA); PG8_STAGE(PG8_SB(1, 1), cB + hstep + kstep, voffB);
        PG8_WAIT_V(6); PG8_BAR;
    } else {
        PG8_STAGE(PG8_SB(0, 0), cB, voffB); PG8_STAGE(PG8_SA(0, 0), cA, voffA); PG8_STAGE(PG8_SB(0, 1), cB + hstep, voffB); PG8_STAGE(PG8_SA(0, 1), cA + hstep, voffA);
        if (wr == 1) PG8_BAR;
        PG8_WAIT_V(4); PG8_BAR;
        PG8_STAGE(PG8_SB(1, 0), cB + kstep, voffB); PG8_STAGE(PG8_SA(1, 0), cA + kstep, voffA); PG8_STAGE(PG8_SB(1, 1), cB + hstep + kstep, voffB);
        PG8_WAIT_V(6); PG8_BAR;
    }
    for (;;) {
        const bool has_next = S.next(ui + 1, nxt);
        const char* nA = has_next ? (const char*)g.A + (size_t)nxt.pm * tstep + (size_t)nxt.koff * 2 : cA; const char* nB = has_next ? (const char*)g.Bt + (size_t)nxt.pn * tstep + (size_t)nxt.koff * 2 : cB;
#pragma nounroll
        for (int t = 0; t < nt; t += 2) {
            const bool last = (t == nt - 2);
            const char* a1 = cA + (size_t)(t + 1) * kstep;
            const char* a2 = last ? nA : cA + (size_t)(t + 2) * kstep; const char* b2 = last ? nB : cB + (size_t)(t + 2) * kstep;
            const char* a3 = a2 + kstep; const char* b3 = b2 + kstep;
            if (last && has_next) S.a_ready(nxt);
            if constexpr (SP2) {
            PG8_LDB(B0, 0, 0); PG8_LDB(B1, 0, 1); PG8_SCHED; PG8_LDA(At, 0, 0); PG8_STAGE(PG8_SA(1, 1), a1 + hstep, voffA);
            PG8_WAIT_V(8); PG8_WAIT_L(0); PG8_BAR; PG8_MMA(0, 0, At, B0); PG8_MMA(0, 1, At, B1); PG8_BAR; PG8_SCHED;
            PG8_LDA(At, 0, 1); PG8_STAGE(PG8_SB(0, 0), b2, voffB); PG8_STAGE(PG8_SB(0, 1), b2 + hstep, voffB); PG8_STAGE(PG8_SA(0, 0), a2, voffA);
            PG8_WAIT_V(8); PG8_WAIT_L(0); PG8_BAR; PG8_MMA(1, 0, At, B0); PG8_MMA(1, 1, At, B1); PG8_BAR; PG8_SCHED;
            PG8_LDB(B0, 1, 0); PG8_LDB(B1, 1, 1); PG8_SCHED; PG8_LDA(At, 1, 0); PG8_STAGE(PG8_SA(0, 1), a2 + hstep, voffA);
            PG8_WAIT_V(8); PG8_WAIT_L(0); PG8_BAR; PG8_MMA(0, 0, At, B0); PG8_MMA(0, 1, At, B1); PG8_BAR; PG8_SCHED;
            PG8_LDA(At, 1, 1); PG8_STAGE(PG8_SB(1, 0), b3, voffB); PG8_STAGE(PG8_SB(1, 1), b3 + hstep, voffB); PG8_STAGE(PG8_SA(1, 0), a3, voffA);
            PG8_WAIT_V(8); PG8_WAIT_L(0); PG8_BAR; PG8_MMA(1, 0, At, B0); PG8_MMA(1, 1, At, B1); PG8_BAR; PG8_SCHED;
            } else {
            PG8_LDB(B0, 0, 0); PG8_SCHED; PG8_LDA(At, 0, 0); PG8_STAGE(PG8_SA(1, 1), a1 + hstep, voffA);
            PG8_WAIT_L(8); PG8_BAR; PG8_WAIT_L(0); PG8_MMA(0, 0, At, B0); PG8_BAR; PG8_SCHED;
            PG8_LDB(B1, 0, 1); PG8_STAGE(PG8_SB(0, 0), b2, voffB);
            PG8_BAR; PG8_WAIT_L(0); PG8_MMA(0, 1, At, B1); PG8_BAR;
            PG8_LDA(At, 0, 1); PG8_STAGE(PG8_SA(0, 0), a2, voffA);
            PG8_BAR; PG8_WAIT_L(0); PG8_MMA(1, 0, At, B0); PG8_BAR; PG8_SCHED;
            PG8_STAGE(PG8_SB(0, 1), b2 + hstep, voffB);
            PG8_WAIT_V(6); PG8_BAR; PG8_MMA(1, 1, At, B1); PG8_BAR;
            PG8_LDB(B0, 1, 0); PG8_SCHED; PG8_LDA(At, 1, 0); PG8_STAGE(PG8_SA(0, 1), a2 + hstep, voffA);
            PG8_WAIT_L(8); PG8_BAR; PG8_WAIT_L(0); PG8_MMA(0, 0, At, B0); PG8_BAR; PG8_SCHED;
            PG8_LDB(B1, 1, 1); PG8_STAGE(PG8_SB(1, 0), b3, voffB);
            PG8_BAR; PG8_WAIT_L(0); PG8_MMA(0, 1, At, B1); PG8_BAR;
            PG8_LDA(At, 1, 1); PG8_STAGE(PG8_SA(1, 0), a3, voffA);
            PG8_BAR; PG8_WAIT_L(0); PG8_MMA(1, 0, At, B0); PG8_BAR; PG8_SCHED;
            PG8_STAGE(PG8_SB(1, 1), b3 + hstep, voffB);
            PG8_WAIT_V(6); PG8_BAR; PG8_MMA(1, 1, At, B1); PG8_BAR;
            }
        }
        if constexpr (F8) {
#define PG8_A4(a, b) "+v"(acc[a][b][0][0]), "+v"(acc[a][b][0][1]), "+v"(acc[a][b][1][0]), "+v"(acc[a][b][1][1]), "+v"(acc[a][b][2][0]), "+v"(acc[a][b][2][1]), "+v"(acc[a][b][3][0]), "+v"(acc[a][b][3][1])
            asm volatile("s_nop 15\n\ts_nop 7" : PG8_A4(0, 0), PG8_A4(0, 1)); asm volatile("" : PG8_A4(1, 0), PG8_A4(1, 1));
#undef PG8_A4
        }
        if constexpr (ALIGN_EPI) { if (wr == 0) PG8_BAR; }
        if constexpr (!Epi::AFTER_DRAIN) { E(acc, cur, wr, wc, fr, fq); S.done(cur); }
        if (!has_next) break;
#pragma unroll
        for (int a = 0; a < 2; ++a)
#pragma unroll
            for (int b = 0; b < 2; ++b)
#pragma unroll
                for (int m = 0; m < 4; ++m)
#pragma unroll
                    for (int n = 0; n < 2; ++n) acc[a][b][m][n] = (f32x4){0.f, 0.f, 0.f, 0.f};
        cur = nxt; cA = nA; cB = nB; ++ui;
        if constexpr (ALIGN_EPI) { if (wr == 1) PG8_BAR; }
    }
    PG8_WAIT_V(0);
    if constexpr (!ALIGN_EPI) { if (wr == 0) PG8_BAR; }
    PG8_BAR;
    if constexpr (Epi::AFTER_DRAIN) { E.fused(acc, cur, wr, wc, fr, fq, lds, wid, lane); S.done(cur); }
#undef PG8_SA
#undef PG8_SB
#undef PG8_STAGE
#undef PG8_LDA
#undef PG8_LDB
#undef PG8_MMA
#undef PG8_WAIT_V
#undef PG8_WAIT_L
#undef PG8_BAR
#undef PG8_SCHED
}
}

constexpr int NWAVES = 8, NTHR = NWAVES * 64;
#ifndef MK_N_LAUNCHES
#define MK_N_LAUNCHES 1
#endif
constexpr int NB = 4, S = 8192, D = 1024, T = NB * S;
constexpr int NH = 8, HD = 64, GW = 512;
constexpr int IN0 = 2208, IN0P = 2304, RWC = 1792;
constexpr int C_R = 0, C_K = 512, C_V = 1024, C_WD = 1536, C_AD = 1600, C_GD = 1664, C_QL = 1792, C_KVL = 2048, C_KR = 2176;
constexpr int QR = 256, KVR = 128, ROPE_M = 32, MLA_QH = 96;
constexpr int DFF = 2816, IN1 = 3080, IN1P = 3072, NE = 8, DE = 3584;
constexpr int MOBA_BLK = 256, MOBA_NB = S / MOBA_BLK;
constexpr int XG_ROWS = 2 * T + NE * 256;
constexpr int MOE_PASS_TILES = 256, MOE_MAX_TILES = 264, MOE_NPASS = 1, MOE_XTILES = 8, MOE_HID_TILES = MOE_PASS_TILES + MOE_XTILES, MOE_KSPLIT = 7;
constexpr float NORM_EPS = 1e-6f, GN_EPS = 64e-5f;

constexpr size_t MiB = 1u << 20;
constexpr size_t WS_CTL = 0, CTL_ZERO_BYTES = 1 * MiB;
constexpr size_t WS_ROPE32 = 1 * MiB;
constexpr size_t WS_ROPE64 = 2 * MiB;
constexpr size_t WS_KPE = 4 * MiB;
constexpr size_t WS_LOGF = 6 * MiB;
constexpr size_t WS_DCUM = 7 * MiB;
constexpr size_t WS_SEL = 8 * MiB;
constexpr size_t WS_KMEAN = 9 * MiB;
constexpr size_t WS_TOPE = 10 * MiB;
constexpr size_t WS_TOPP = 10 * MiB + 512 * 1024;
constexpr size_t WS_TOPG = 11 * MiB;
constexpr size_t WS_PROW = 11 * MiB + 512 * 1024;
constexpr size_t WS_SSQ = 13 * MiB;
constexpr size_t WS_TILEE = 12 * MiB;
constexpr size_t WS_WIN0 = 16 * MiB;
constexpr size_t WS_WLORA = 21 * MiB;
constexpr size_t WS_WUQ = 22 * MiB;
constexpr size_t WS_WUKV = 23 * MiB;
constexpr size_t WS_WOUT0 = 24 * MiB;
constexpr size_t WS_WGU0 = 26 * MiB;
constexpr size_t WS_WD0 = 37 * MiB;
constexpr size_t WS_WIN1 = 43 * MiB;
constexpr size_t WS_WOUT1 = 49 * MiB;
constexpr size_t WS_XN = 52 * MiB;
constexpr size_t WS_HB = 52 * MiB;
constexpr size_t WS_XNF = 292 * MiB;
constexpr size_t WS_XNL1 = 308 * MiB;
constexpr size_t WS_KVM = WS_XN;
constexpr size_t WS_BIG = 116 * MiB;
constexpr size_t WS_PROJ0 = WS_BIG;
constexpr size_t WS_EW = WS_BIG, WS_AA = WS_BIG + 32 * MiB, WS_GG = WS_BIG + 64 * MiB;
constexpr size_t WS_QM = WS_BIG + 96 * MiB;
constexpr size_t WS_YRAW = WS_BIG + 144 * MiB;
constexpr size_t WS_HID = WS_BIG;
constexpr size_t WS_PROJ1 = WS_BIG;
constexpr size_t WS_LIN = 308 * MiB;
constexpr size_t WS_QN = 324 * MiB;
constexpr size_t WS_KVN = 340 * MiB;
constexpr size_t WS_RKV = 348 * MiB;
constexpr size_t WS_YMIX = 446 * MiB;
constexpr size_t WS_XN2 = WS_YMIX;
constexpr size_t WS_WMOE_GU = 116 * MiB;
constexpr size_t WS_WMOE_D = 16 * MiB;
constexpr size_t WS_XG = 116 * MiB;
constexpr size_t WS_HIDM = 248 * MiB;
constexpr size_t WS_XG8 = 172 * MiB;
using pg8::F8_SX; using pg8::F8_SW1; using pg8::F8_SH; using pg8::F8_SW2;
constexpr size_t WS_QLIST = 16 * MiB;
constexpr size_t WS_PARTO = 308 * MiB;
constexpr size_t WS_PARTML = 436 * MiB;
constexpr size_t WS_YP = 479 * MiB;
constexpr size_t WS_END = 510 * MiB;
static_assert(WS_WMOE_D + (size_t)NE * D * DE <= WS_HB && WS_HB + (size_t)T * D * 2 <= WS_WMOE_GU && WS_WMOE_GU + (size_t)NE * 2 * DE * D <= WS_XG8 && WS_XG8 + (size_t)XG_ROWS * 1024 <= WS_HIDM && WS_XG >= WS_WMOE_GU &&
              WS_XG + (size_t)XG_ROWS * 1024 * 2 <= WS_HIDM && WS_HIDM + (size_t)MOE_HID_TILES * 256 * DE <= WS_YP && WS_YP + (size_t)MOE_KSPLIT * MOE_XTILES * 256 * D * 2 <= WS_END && WS_XN2 >= WS_XG8 + (size_t)XG_ROWS * 1024, "MoE map (the bf16 residual stream WS_HB stays alive through it)");
static_assert(WS_YRAW + (size_t)T * 512 * 4 <= WS_QN && WS_RKV + (size_t)T * 1536 * 2 <= WS_YMIX && WS_QM + (size_t)T * 768 * 2 <= WS_YRAW, "layer-0 map");
constexpr int CW_BAR = 4096;
constexpr int CW_CNT = 16384;
constexpr int CW_MOBA = 32768;
constexpr int CW_Q0 = 16384 + 64, CW_Q1 = 16384 + 128;

constexpr int RING_OFF = 0, RING_BYTES = 131072;
constexpr int LDSCTL_OFF = RING_BYTES, MISC_OFF = LDSCTL_OFF + 320;
constexpr int LDS_BYTES = 147456;

#define GAS __attribute__((address_space(1)))
#define LAS __attribute__((address_space(3)))
typedef unsigned short bf16;
typedef unsigned v4u __attribute__((ext_vector_type(4)));
typedef unsigned v2u __attribute__((ext_vector_type(2)));
typedef float f32x4 __attribute__((ext_vector_type(4)));
typedef GAS unsigned gu32;
#define RLX_AGENT __ATOMIC_RELAXED, __HIP_MEMORY_SCOPE_AGENT
#define LDS_WAIT() asm volatile("s_waitcnt lgkmcnt(0)" ::: "memory")
#define VM_WAIT() asm volatile("s_waitcnt vmcnt(0)" ::: "memory")
__device__ __forceinline__ unsigned f2bf(float f) { unsigned u = __builtin_bit_cast(unsigned, f); return (u + 0x7fffu + ((u >> 16) & 1u)) >> 16; }
__device__ __forceinline__ unsigned pk2(float lo, float hi) { return f2bf(lo) | (f2bf(hi) << 16); }
__device__ __forceinline__ float bflo(unsigned w) { return __builtin_bit_cast(float, w << 16); }
__device__ __forceinline__ float bfhi(unsigned w) { return __builtin_bit_cast(float, w & 0xffff0000u); }
__device__ __forceinline__ float bf1(bf16 h) { return __builtin_bit_cast(float, (unsigned)h << 16); }
__device__ __forceinline__ float sigm(float x) { return 1.0f / (1.0f + __expf(-x)); }
__device__ __forceinline__ float wave_sum(float v) {
#pragma unroll
    for (int o = 1; o < 64; o <<= 1) v += __shfl_xor(v, o);
    return v;
}
template <int CTRL> __device__ __forceinline__ float dpp_mov(float v) { return __builtin_bit_cast(float, __builtin_amdgcn_update_dpp(0, __builtin_bit_cast(int, v), CTRL, 0xf, 0xf, false)); }
__device__ __forceinline__ float rowsum16(float v) {
    v += dpp_mov<0xB1>(v); v += dpp_mov<0x4E>(v); v += dpp_mov<0x124>(v); v += dpp_mov<0x128>(v); return v;
}

#define XB_TMO      128
#define XB_XCNT(j)  (256  + 64 * (j))
#define XB_XSUB(j)  (1280 + 64 * (j))
#define XB_XGEN(j)  (2304 + 64 * (j))
#define XB_TOP      3328
#define XB_TOPGEN   3392
#define XCD_BAR_WORDS 3456
#define XB_SPIN_CAP (1u << 18)

__device__ __forceinline__ unsigned xb_ld(unsigned* p)              { return __hip_atomic_load(p, __ATOMIC_RELAXED, __HIP_MEMORY_SCOPE_AGENT); }
__device__ __forceinline__ unsigned xb_add(unsigned* p, unsigned v) { return __hip_atomic_fetch_add(p, v, __ATOMIC_RELAXED, __HIP_MEMORY_SCOPE_AGENT); }
__device__ __forceinline__ unsigned xb_xcc_id() { return (unsigned)__builtin_amdgcn_s_getreg((3 << 11) | 20) & 0xFu; }
#define XB_SPIN(cond, bar) do { unsigned _sp = 0; while (cond) { __builtin_amdgcn_s_sleep(1); \
    if ((++_sp & 255u) == 0u) { if (xb_ld(&(bar)[XB_TMO])) break; if (_sp > XB_SPIN_CAP) { atomicAdd(&(bar)[XB_TMO], 1u); break; } } } } while (0)

struct XcdBarrier {
    unsigned* bar; unsigned x;
    volatile LAS unsigned* st;
};

__device__ __forceinline__ XcdBarrier xcd_barrier_post(unsigned* bar, volatile LAS unsigned* st) {
    XcdBarrier b; b.bar = bar; b.x = xb_xcc_id(); b.st = st;
    if (threadIdx.x == 0) (void)xb_add(&bar[XB_XCNT(b.x)], 1u);
    return b;
}
__device__ __forceinline__ void xcd_barrier_complete(unsigned* bar, unsigned x, unsigned& nloc, unsigned& nx) {
    const unsigned G = gridDim.x * gridDim.y * gridDim.z;
    unsigned sum, cnt, mine, sp = 0u;
    for (;;) {
        sum = 0u; cnt = 0u; mine = 0u;
#pragma unroll
        for (unsigned j = 0; j < 16; ++j) { const unsigned c = xb_ld(&bar[XB_XCNT(j)]); sum += c; cnt += (c > 0u) ? 1u : 0u; mine = (j == x) ? c : mine; }
        if (sum == G) break;
        __builtin_amdgcn_s_sleep(1);
        if ((++sp & 255u) == 0u) { if (xb_ld(&bar[XB_TMO])) break; if (sp > XB_SPIN_CAP) { atomicAdd(&bar[XB_TMO], 1u); break; } }
    }
    nloc = mine > 0u ? mine : 1u; nx = cnt > 0u ? cnt : 1u;
}

__device__ __forceinline__ void xcd_barrier(const XcdBarrier& b) {
    asm volatile("s_waitcnt vmcnt(0)" ::: "memory");
    __syncthreads();
    if (threadIdx.x == 0) {
        unsigned* bar = b.bar;
        __builtin_amdgcn_s_waitcnt(0);
        unsigned nloc = b.st[0], nx = b.st[1];
        if (nloc == 0u) { xcd_barrier_complete(bar, b.x, nloc, nx); b.st[0] = nloc; b.st[1] = nx; }
        const unsigned old = xb_add(&bar[XB_XSUB(b.x)], 1u);
        const unsigned gen = old / nloc;
        if (old + 1u == (gen + 1u) * nloc) {
            __builtin_amdgcn_fence(__ATOMIC_RELEASE, "agent");
            asm volatile("s_waitcnt vmcnt(0)" ::: "memory");
            const unsigned og = xb_add(&bar[XB_TOP], 1u);
            const unsigned tg = og / nx;
            if (og + 1u == (tg + 1u) * nx) xb_add(&bar[XB_TOPGEN], 1u);
            else XB_SPIN(xb_ld(&bar[XB_TOPGEN]) == tg, bar);
            __builtin_amdgcn_fence(__ATOMIC_ACQUIRE, "agent");
            xb_add(&bar[XB_XGEN(b.x)], 1u);
            asm volatile("s_waitcnt vmcnt(0)" ::: "memory");
        } else {
            XB_SPIN(xb_ld(&bar[XB_XGEN(b.x)]) == gen, bar);
            __builtin_amdgcn_fence(__ATOMIC_ACQUIRE, "agent");
            asm volatile("s_waitcnt vmcnt(0)" ::: "memory");
        }
    }
    __syncthreads();
}

struct Args { const float* in[33]; float* out; unsigned char* ws; int ph_lo, ph_hi; };
struct Frame {
    LAS unsigned char* lds; unsigned char* ws; float* H;
    int tid, lane, wave, G, bid;
};
template <class Tp> __device__ __forceinline__ Tp* wsp(const Frame& F, size_t off) { return (Tp*)(F.ws + off); }
__device__ __forceinline__ const float* kin(int i) { return ((const float* const __attribute__((address_space(4)))*)__builtin_amdgcn_kernarg_segment_ptr())[i]; }

__device__ __forceinline__ void tr_item(const float* W, int ldw, int k0, int nsrc0, bf16* WT, int kp, int rdst0, LAS float* scr, int lane, const float* kgain = nullptr) {
#pragma unroll
    for (int i = 0; i < 8; ++i) { const int kk = 8 * i + (lane >> 3), n4 = (lane & 7) * 4; const f32x4 x = __builtin_nontemporal_load((const f32x4*)(W + (size_t)(k0 + kk) * ldw + nsrc0 + n4));
        const float g = kgain ? kgain[k0 + kk] : 1.0f; LAS float* d = scr + kk * 33 + n4; d[0] = x.x * g; d[1] = x.y * g; d[2] = x.z * g; d[3] = x.w * g; }
    LDS_WAIT(); asm volatile("" ::: "memory");
    const int c = lane & 7;
#pragma unroll
    for (int j = 0; j < 4; ++j) { const int n = (lane >> 3) + 8 * j; const LAS float* s = scr + (8 * c) * 33 + n;
        v4u o; o.x = pk2(s[0 * 33], s[1 * 33]); o.y = pk2(s[2 * 33], s[3 * 33]); o.z = pk2(s[4 * 33], s[5 * 33]); o.w = pk2(s[6 * 33], s[7 * 33]);
        *(v4u*)(WT + (size_t)(rdst0 + n) * kp + k0 + 8 * c) = o; }
    LDS_WAIT(); asm volatile("" ::: "memory");
}
template <int MODE> __device__ __forceinline__ void tr_matrix(const Frame& F, int& itbase, const float* W, int ldw, int K, int nsrc0, int nblk, bf16* WT, int kp, int rdst0, LAS float* scr, const float* kgain = nullptr) {
    const int gw = F.bid * NWAVES + F.wave, NGW = F.G * NWAVES; const int nit = (K / 64) * nblk;
    int first = (gw - itbase % NGW + NGW) % NGW;
    for (int it = first; it < nit; it += NGW) { const int kb = it / nblk, nb = it % nblk, n = 32 * nb;
        const int rd = MODE == 0 ? rdst0 + n : 256 * (n >> 7) + (n & 127) + rdst0;
        tr_item(W, ldw, 64 * kb, nsrc0 + n, WT, kp, rd, scr, F.lane, kgain); }
    itbase += nit;
}
__device__ __forceinline__ void tr_item8(const float* W, int ldw, int k0, int nsrc0, unsigned char* WT, int kp, int rdst0, LAS float* scr, int lane, float sc) {
#pragma unroll
    for (int i = 0; i < 8; ++i) { const int kk = 8 * i + (lane >> 3), n4 = (lane & 7) * 4; const f32x4 x = __builtin_nontemporal_load((const f32x4*)(W + (size_t)(k0 + kk) * ldw + nsrc0 + n4));
        LAS float* d = scr + kk * 33 + n4; d[0] = x.x * sc; d[1] = x.y * sc; d[2] = x.z * sc; d[3] = x.w * sc; }
    LDS_WAIT(); asm volatile("" ::: "memory");
    const int c = lane & 3;
#pragma unroll
    for (int j = 0; j < 2; ++j) { const int n = (lane >> 2) + 16 * j; const LAS float* s = scr + (16 * c) * 33 + n;
        v4u o; o.x = pg8::pk4_fp8(s[0 * 33], s[1 * 33], s[2 * 33], s[3 * 33]); o.y = pg8::pk4_fp8(s[4 * 33], s[5 * 33], s[6 * 33], s[7 * 33]);
        o.z = pg8::pk4_fp8(s[8 * 33], s[9 * 33], s[10 * 33], s[11 * 33]); o.w = pg8::pk4_fp8(s[12 * 33], s[13 * 33], s[14 * 33], s[15 * 33]);
        *(v4u*)(WT + (size_t)(rdst0 + n) * kp + k0 + 16 * c) = o; }
    LDS_WAIT(); asm volatile("" ::: "memory");
}
template <int MODE> __device__ __forceinline__ void tr_matrix8(const Frame& F, int& itbase, const float* W, int ldw, int K, int nsrc0, int nblk, unsigned char* WT, int kp, int rdst0, LAS float* scr, float sc) {
    const int gw = F.bid * NWAVES + F.wave, NGW = F.G * NWAVES; const int nit = (K / 64) * nblk;
    int first = (gw - itbase % NGW + NGW) % NGW;
    for (int it = first; it < nit; it += NGW) { const int kb = it / nblk, nb = it % nblk, n = 32 * nb;
        const int rd = MODE == 0 ? rdst0 + n : 256 * (n >> 7) + (n & 127) + rdst0;
        tr_item8(W, ldw, 64 * kb, nsrc0 + n, WT, kp, rd, scr, F.lane, sc); }
    itbase += nit;
}
__device__ __forceinline__ void rms_load(const Frame& F, const float* xrow, f32x4 (&v)[4]) {
    const f32x4* xr = (const f32x4*)xrow + F.lane;
#pragma unroll
    for (int j = 0; j < 4; ++j) v[j] = xr[64 * j];
}
__device__ __forceinline__ void rms_load(const Frame& F, const bf16* xrow, f32x4 (&v)[4]) {
    const v2u* xr = (const v2u*)xrow + F.lane;
#pragma unroll
    for (int j = 0; j < 4; ++j) { const v2u w = xr[64 * j]; v[j] = (f32x4){bflo(w.x), bfhi(w.x), bflo(w.y), bfhi(w.y)}; }
}
__device__ __forceinline__ void rms_finish(const Frame& F, const f32x4 (&gq)[4], bf16* orow, f32x4 (&v)[4]) {
    float s = 0.f;
#pragma unroll
    for (int j = 0; j < 4; ++j) s += (v[j].x * v[j].x + v[j].y * v[j].y) + (v[j].z * v[j].z + v[j].w * v[j].w);
    const float rstd = 1.0f / sqrtf(wave_sum(s) * (1.f / D) + NORM_EPS);
    unsigned long long* o8 = (unsigned long long*)orow + F.lane;
#pragma unroll
    for (int j = 0; j < 4; ++j) { const f32x4 g = gq[j]; v[j] = v[j] * rstd * g;
        o8[64 * j] = (unsigned long long)pk2(v[j].x, v[j].y) | ((unsigned long long)pk2(v[j].z, v[j].w) << 32); }
}
__device__ __forceinline__ void rms_finish(const Frame& F, const f32x4 (&gq)[4], unsigned char* orow, f32x4 (&v)[4]) {
    float s = 0.f;
#pragma unroll
    for (int j = 0; j < 4; ++j) s += (v[j].x * v[j].x + v[j].y * v[j].y) + (v[j].z * v[j].z + v[j].w * v[j].w);
    const float rstd = 1.0f / sqrtf(wave_sum(s) * (1.f / D) + NORM_EPS);
    unsigned* o4 = (unsigned*)orow + F.lane;
#pragma unroll
    for (int j = 0; j < 4; ++j) { const f32x4 g = gq[j]; v[j] = v[j] * rstd * g;
        o4[64 * j] = pg8::pk4_fp8(F8_SX * v[j].x, F8_SX * v[j].y, F8_SX * v[j].z, F8_SX * v[j].w); }
}
__device__ __forceinline__ void rms_row(const Frame& F, const float* xrow, const float* gain, bf16* orow, f32x4 (&v)[4]) { f32x4 gq[4]; for (int j = 0; j < 4; ++j) gq[j] = ((const f32x4*)gain)[F.lane + 64 * j]; rms_load(F, xrow, v); rms_finish(F, gq, orow, v); }
#define RMS_ROWS(src, gain, dst, BODY) do { f32x4 va[4], vb[4], gq_[4]; _Pragma("unroll") for (int j_ = 0; j_ < 4; ++j_) gq_[j_] = ((const f32x4*)(gain))[F.lane + 64 * j_]; int m = gw; if (m < T) rms_load(F, (src) + (size_t)m * D, va); \
        for (; m < T; m += 2 * NGW) { if (m + NGW < T) rms_load(F, (src) + (size_t)(m + NGW) * D, vb); \
            rms_finish(F, gq_, (dst) + (size_t)m * D, va); { const int mm = m; f32x4 (&v)[4] = va; (void)v; BODY; } \
            if (m + NGW < T) { if (m + 2 * NGW < T) rms_load(F, (src) + (size_t)(m + 2 * NGW) * D, va); \
                rms_finish(F, gq_, (dst) + (size_t)(m + NGW) * D, vb); { const int mm = m + NGW; f32x4 (&v)[4] = vb; (void)v; BODY; } } } } while (0)
__device__ __forceinline__ void stage_w8(const Frame& F, const float* W, int ldw, int c0) {
    LAS float* WL = (LAS float*)(F.lds + 65536);
    for (int k = F.tid; k < D; k += NTHR) { const int lane = (k & 255) >> 2, j = k >> 8, q = k & 3; const float* wr = W + (size_t)k * ldw + c0;
#pragma unroll
        for (int e = 0; e < 8; ++e) WL[((j * 4 + q) * 64 + lane) * 8 + e] = wr[e]; }
    __syncthreads();
}
__device__ __forceinline__ void row_dot8(const Frame& F, const f32x4 (&v)[4], float (&o)[8]) {
    const LAS float* WL = (const LAS float*)(F.lds + 65536); const int lane = F.lane;
    float a[8];
#pragma unroll
    for (int e = 0; e < 8; ++e) a[e] = 0.f;
#pragma unroll
    for (int j = 0; j < 4; ++j)
#pragma unroll
        for (int q = 0; q < 4; ++q) { const float xv = v[j][q]; const LAS f32x4* wp = (const LAS f32x4*)(WL + ((j * 4 + q) * 64 + lane) * 8); const f32x4 w0 = wp[0], w1 = wp[1];
            a[0] += xv * w0.x; a[1] += xv * w0.y; a[2] += xv * w0.z; a[3] += xv * w0.w; a[4] += xv * w1.x; a[5] += xv * w1.y; a[6] += xv * w1.z; a[7] += xv * w1.w; }
    const bool b5 = lane & 32, b4 = lane & 16, b3 = lane & 8;
    float c4[4];
#pragma unroll
    for (int i = 0; i < 4; ++i) { const float keep = b5 ? a[4 + i] : a[i], send = b5 ? a[i] : a[4 + i]; c4[i] = keep + __shfl_xor(send, 32); }
    float c2[2];
#pragma unroll
    for (int i = 0; i < 2; ++i) { const float keep = b4 ? c4[2 + i] : c4[i], send = b4 ? c4[i] : c4[2 + i]; c2[i] = keep + __shfl_xor(send, 16); }
    float c1; { const float keep = b3 ? c2[1] : c2[0], send = b3 ? c2[0] : c2[1]; c1 = keep + __shfl_xor(send, 8); }
    c1 += __shfl_xor(c1, 4); c1 += __shfl_xor(c1, 2); c1 += __shfl_xor(c1, 1);
#pragma unroll
    for (int e = 0; e < 8; ++e) o[e] = __builtin_bit_cast(float, __builtin_amdgcn_readlane(__builtin_bit_cast(int, c1), 8 * e));
}

__device__ __forceinline__ void p0_prologue(const Frame& F, const Args& a) {
    LAS float* scr = (LAS float*)(F.lds + F.wave * 16384);
    const int gw = F.bid * NWAVES + F.wave, NGW = F.G * NWAVES, gt = F.bid * NTHR + F.tid, NGT = F.G * NTHR;
    int itb = 0;
    tr_matrix<0>(F, itb, kin(2), IN0, D, 0, IN0 / 32, wsp<bf16>(F, WS_WIN0), D, 0, scr);
    tr_matrix<0>(F, itb, kin(15), 768, QR, 0, 768 / 32, wsp<bf16>(F, WS_WUQ), QR, 0, scr);
    tr_matrix<0>(F, itb, kin(17), 1024, KVR, 0, 1024 / 32, wsp<bf16>(F, WS_WUKV), KVR, 0, scr);
    tr_matrix<0>(F, itb, kin(18), D, D, 0, D / 32, wsp<bf16>(F, WS_WOUT0), D, 0, scr);
    tr_matrix<1>(F, itb, kin(20), DFF, D, 0, DFF / 32, wsp<bf16>(F, WS_WGU0), D, 0, scr);
    tr_matrix<1>(F, itb, kin(21), DFF, D, 0, DFF / 32, wsp<bf16>(F, WS_WGU0), D, 128, scr);
    tr_matrix<0>(F, itb, kin(22), D, DFF, 0, D / 32, wsp<bf16>(F, WS_WD0), DFF, 0, scr);
    tr_matrix<0>(F, itb, kin(24), IN1, D, 0, 1536 / 32, wsp<bf16>(F, WS_WIN1), D, 0, scr);
    tr_matrix<0>(F, itb, kin(24), IN1, D, 1544, 1536 / 32, wsp<bf16>(F, WS_WIN1), D, 1536, scr);
    tr_matrix<0>(F, itb, kin(26), D, D, 0, D / 32, wsp<bf16>(F, WS_WOUT1), D, 0, scr);
    { unsigned* z = (unsigned*)(wsp<bf16>(F, WS_WIN0) + (size_t)IN0 * D); for (int i = gt; i < (IN0P - IN0) * D / 2; i += NGT) z[i] = 0u; }
    { bf16* L = wsp<bf16>(F, WS_WLORA); const float* w2 = kin(5); const float* a2 = kin(7); const float* g2 = kin(8);
      for (int i = gt; i < 1536 * 256; i += NGT) { const int n = i >> 8, k = i & 255; float v = 0.f;
          if (n < 512) { if (k < 64) v = w2[k * 512 + n]; } else if (n < 1024) { if (k >= 64 && k < 128) v = a2[(k - 64) * 512 + (n - 512)]; } else { if (k >= 128) v = g2[(k - 128) * 512 + (n - 1024)]; }
          L[i] = (bf16)f2bf(v); } }
    { float* r32 = wsp<float>(F, WS_ROPE32); float* r64 = wsp<float>(F, WS_ROPE64);
      for (int i = gt; i < S * 16; i += NGT) { const int pos = i >> 4, j = i & 15; const float inv = powf(10000.0f, -(float)(2 * j) / 32.0f); const float ang = (float)pos * inv; r32[2 * i] = cosf(ang); r32[2 * i + 1] = sinf(ang); }
      for (int i = gt; i < S * 32; i += NGT) { const int pos = i >> 5, j = i & 31; const float inv = powf(10000.0f, -(float)(2 * j) / 64.0f); const float ang = (float)pos * inv; r64[2 * i] = cosf(ang); r64[2 * i + 1] = sinf(ang); } }
    RMS_ROWS(kin(0), kin(1), wsp<bf16>(F, WS_XN), (void)mm);
}

typedef float f32x2_t __attribute__((ext_vector_type(2)));
struct P2Raw { v4u rkv[3]; v2u lin, ql; unsigned kvl; bf16 x1, x2; float rc, rs; };
__device__ __forceinline__ void p2_load(P2Raw& q, const bf16* cur, const float* r32, int pos, int lane) {
#pragma unroll
    for (int c = 0; c < 3; ++c) q.rkv[c] = *(const v4u*)(cur + c * 512 + lane * 8);
    q.lin = *(const v2u*)(cur + C_WD + 4 * lane); q.ql = *(const v2u*)(cur + C_QL + 4 * lane); q.kvl = *(const unsigned*)(cur + C_KVL + 2 * lane);
    q.x1 = cur[C_KR + (lane & 15)]; q.x2 = cur[C_KR + 16 + (lane & 15)]; const f32x2_t cs = *(const f32x2_t*)(r32 + (pos * 16 + (lane & 15)) * 2); q.rc = cs[0]; q.rs = cs[1];
}
__device__ __forceinline__ void p2_prep0(const Frame& F, const Args& a) {
    const int gw = F.bid * NWAVES + F.wave, NGW = F.G * NWAVES, lane = F.lane;
    const bf16* P = wsp<bf16>(F, WS_PROJ0); const float* mu = kin(3);
    bf16* RKV = wsp<bf16>(F, WS_RKV); bf16* LIN = wsp<bf16>(F, WS_LIN); bf16* QN = wsp<bf16>(F, WS_QN); bf16* KVN = wsp<bf16>(F, WS_KVN); bf16* KPE = wsp<bf16>(F, WS_KPE);
    const float* r32 = wsp<float>(F, WS_ROPE32);
    const int run = (T + NGW - 1) / NGW, t0 = gw * run, t1 = t0 + run < T ? t0 + run : T;
    if (t0 >= t1) return;
    float mrkv[3][8], mlin[4], gq[4], gkv[2];
#pragma unroll
    for (int c = 0; c < 3; ++c) { const f32x4 m0 = *(const f32x4*)(mu + c * 512 + lane * 8), m1 = *(const f32x4*)(mu + c * 512 + lane * 8 + 4);
#pragma unroll
        for (int e = 0; e < 4; ++e) { mrkv[c][e] = m0[e]; mrkv[c][4 + e] = m1[e]; } }
    { const f32x4 m = *(const f32x4*)(mu + C_WD + 4 * lane), g = *(const f32x4*)(kin(14) + 4 * lane); const f32x2_t k = *(const f32x2_t*)(kin(16) + 2 * lane);
#pragma unroll
      for (int e = 0; e < 4; ++e) { mlin[e] = m[e]; gq[e] = g[e]; }
      gkv[0] = k[0]; gkv[1] = k[1]; }
    const float fA = lane < 16 ? 2.0f : (lane < 32 ? 0.0f : 1.0f), fB = lane < 16 ? -2.0f * 1.44269504f : (lane < 32 ? 0.0f : -1.44269504f), fC = (lane >= 16 && lane < 32) ? 1.0f : 0.0f, fD = lane < 16 ? -1.0f : 0.0f;
    P2Raw cur, nxt; v4u prkv[3]; v2u plin;
    p2_load(cur, P + (size_t)t0 * IN0P, r32, t0 % S, lane);
    if (t0 % S) { const bf16* pv = P + (size_t)(t0 - 1) * IN0P;
#pragma unroll
        for (int c = 0; c < 3; ++c) prkv[c] = *(const v4u*)(pv + c * 512 + lane * 8);
        plin = *(const v2u*)(pv + C_WD + 4 * lane); }
    else { prkv[0] = prkv[1] = prkv[2] = (v4u){0u, 0u, 0u, 0u}; plin = (v2u){0u, 0u}; }
    for (int t = t0; t < t1; ++t) {
        if (t + 1 < t1) p2_load(nxt, P + (size_t)(t + 1) * IN0P, r32, (t + 1) % S, lane);
        if (t != t0 && (t % S) == 0) { prkv[0] = prkv[1] = prkv[2] = (v4u){0u, 0u, 0u, 0u}; plin = (v2u){0u, 0u}; }
#pragma unroll
        for (int c = 0; c < 3; ++c) { v4u o;
#pragma unroll
            for (int e = 0; e < 4; ++e) { const float c0 = bflo(cur.rkv[c][e]), c1 = bfhi(cur.rkv[c][e]), p0 = bflo(prkv[c][e]), p1 = bfhi(prkv[c][e]);
                o[e] = pk2(c0 + mrkv[c][2 * e] * (p0 - c0), c1 + mrkv[c][2 * e + 1] * (p1 - c1)); }
            *(v4u*)(RKV + (size_t)t * 1536 + c * 512 + lane * 8) = o; }
        { float y[4];
#pragma unroll
          for (int e = 0; e < 2; ++e) { const float c0 = bflo(cur.lin[e]), c1 = bfhi(cur.lin[e]), p0 = bflo(plin[e]), p1 = bfhi(plin[e]);
              const float x0 = c0 + mlin[2 * e] * (p0 - c0), x1 = c1 + mlin[2 * e + 1] * (p1 - c1);
              y[2 * e] = fA * __builtin_amdgcn_rcpf(1.0f + __builtin_amdgcn_exp2f(fB * x0)) + fC * x0 + fD; y[2 * e + 1] = fA * __builtin_amdgcn_rcpf(1.0f + __builtin_amdgcn_exp2f(fB * x1)) + fC * x1 + fD; }
          v2u o; o[0] = pk2(y[0], y[1]); o[1] = pk2(y[2], y[3]); *(v2u*)(LIN + (size_t)t * 256 + 4 * lane) = o; }
        { const float q0 = bflo(cur.ql[0]), q1 = bfhi(cur.ql[0]), q2 = bflo(cur.ql[1]), q3 = bfhi(cur.ql[1]), k0 = bflo(cur.kvl), k1 = bfhi(cur.kvl);
          float sq = (q0 * q0 + q1 * q1) + (q2 * q2 + q3 * q3), sk = k0 * k0 + k1 * k1;
#pragma unroll
          for (int o = 1; o < 64; o <<= 1) { sq += __shfl_xor(sq, o); sk += __shfl_xor(sk, o); }
          const float rq = 1.0f / sqrtf(sq * (1.f / QR) + NORM_EPS), rk = 1.0f / sqrtf(sk * (1.f / KVR) + NORM_EPS);
          v2u o; o[0] = pk2(q0 * rq * gq[0], q1 * rq * gq[1]); o[1] = pk2(q2 * rq * gq[2], q3 * rq * gq[3]); *(v2u*)(QN + (size_t)t * QR + 4 * lane) = o;
          *(unsigned*)(KVN + (size_t)t * KVR + 2 * lane) = pk2(k0 * rk * gkv[0], k1 * rk * gkv[1]); }
        if (lane < 16) { const float x1 = bf1(cur.x1), x2 = bf1(cur.x2); KPE[(size_t)t * 32 + lane] = (bf16)f2bf(x1 * cur.rc - x2 * cur.rs); KPE[(size_t)t * 32 + 16 + lane] = (bf16)f2bf(x2 * cur.rc + x1 * cur.rs); }
#pragma unroll
        for (int c = 0; c < 3; ++c) prkv[c] = cur.rkv[c];
        plin = cur.lin; cur = nxt;
    }
}

constexpr int SC_CH = 32, SC_V = SC_CH * 16 * 80, SC_BUF = SC_V + SC_CH * 16 * 4;
typedef float f32x2 __attribute__((ext_vector_type(2)));
struct ScOp { f32x4 a, w, k, b, r; float v; };
__device__ __forceinline__ void rowsum16x2(float& x, float& y) {
    asm volatile("s_nop 1\n\t"
                 "v_add_f32_dpp %0, %0, %0 quad_perm:[1,0,3,2] row_mask:0xf bank_mask:0xf bound_ctrl:1\n\t"
                 "v_add_f32_dpp %1, %1, %1 quad_perm:[1,0,3,2] row_mask:0xf bank_mask:0xf bound_ctrl:1\n\t"
                 "s_nop 0\n\t"
                 "v_add_f32_dpp %0, %0, %0 quad_perm:[2,3,0,1] row_mask:0xf bank_mask:0xf bound_ctrl:1\n\t"
                 "v_add_f32_dpp %1, %1, %1 quad_perm:[2,3,0,1] row_mask:0xf bank_mask:0xf bound_ctrl:1\n\t"
                 "s_nop 0\n\t"
                 "v_add_f32_dpp %0, %0, %0 row_ror:4 row_mask:0xf bank_mask:0xf bound_ctrl:1\n\t"
                 "v_add_f32_dpp %1, %1, %1 row_ror:4 row_mask:0xf bank_mask:0xf bound_ctrl:1\n\t"
                 "s_nop 0\n\t"
                 "v_add_f32_dpp %0, %0, %0 row_ror:8 row_mask:0xf bank_mask:0xf bound_ctrl:1\n\t"
                 "v_add_f32_dpp %1, %1, %1 row_ror:8 row_mask:0xf bank_mask:0xf bound_ctrl:1\n\t"
                 "s_nop 1" : "+v"(x), "+v"(y));
}
__device__ __forceinline__ float sum8(float v) { v += dpp_mov<0xB1>(v); v += dpp_mov<0x4E>(v); v += dpp_mov<0x141>(v); return v; }
constexpr int SCAN_ITEMS = NB * NH * 4;
__device__ __forceinline__ void rwkv_scan_item(const Frame& F, const Args& a_, int item) {
    const int b = item >> 5, h = (item >> 2) & 7, qtr = item & 3; const int tid = F.tid, lane = tid & 63, wave = __builtin_amdgcn_readfirstlane(tid >> 6);
    LAS unsigned char* L = F.lds;
    constexpr int NCH = S / SC_CH;
    __syncthreads();
    if (wave >= 4) {
        const bf16* RKV = wsp<bf16>(F, WS_RKV); const bf16* EW = wsp<bf16>(F, WS_EW); const bf16* AA = wsp<bf16>(F, WS_AA);
        const int pt = tid - 256, ps = pt >> 3, pc = (pt & 7) * 8; const int ch = h * 64 + pc;
        float kkw[8], kaw[8];
#pragma unroll
        for (int e = 0; e < 8; ++e) { kkw[e] = kin(9)[ch + e]; kaw[e] = kin(10)[ch + e]; }
        for (int c = 0; c <= NCH; ++c) {
            if (c < NCH) { const size_t tok = (size_t)b * S + c * SC_CH + ps; const int bo = (c & 1) * SC_BUF;
                const v4u rw = *(const v4u*)(RKV + tok * 1536 + C_R + ch), kw = *(const v4u*)(RKV + tok * 1536 + C_K + ch), vw = *(const v4u*)(RKV + tok * 1536 + C_V + ch);
                const v4u ew = *(const v4u*)(EW + tok * 512 + ch), aw = *(const v4u*)(AA + tok * 512 + ch);
                float r[8], k[8], v[8], w[8], al[8], kk[8]; float ss = 0.f;
#pragma unroll
                for (int e = 0; e < 4; ++e) { r[2 * e] = bflo(rw[e]); r[2 * e + 1] = bfhi(rw[e]); k[2 * e] = bflo(kw[e]); k[2 * e + 1] = bfhi(kw[e]); v[2 * e] = bflo(vw[e]); v[2 * e + 1] = bfhi(vw[e]);
                    w[2 * e] = bflo(ew[e]); w[2 * e + 1] = bfhi(ew[e]); al[2 * e] = bflo(aw[e]); al[2 * e + 1] = bfhi(aw[e]); }
#pragma unroll
                for (int e = 0; e < 8; ++e) { kk[e] = k[e] * kkw[e]; ss += kk[e] * kk[e]; }
                ss = sum8(ss); const float inv = 1.0f / fmaxf(sqrtf(ss), 1e-12f);
#pragma unroll
                for (int q = 0; q < 2; ++q) { f32x4 oa, ow, ok, ob, orr;
#pragma unroll
                    for (int e = 0; e < 4; ++e) { const int i = 4 * q + e; const float kn = kk[i] * inv; oa[e] = -kn; ow[e] = __expf(-w[i]); ok[e] = k[i] * (1.0f + (al[i] - 1.0f) * kaw[i]); ob[e] = kn * al[i]; orr[e] = r[i]; }
                    LAS f32x4* dst = (LAS f32x4*)(L + bo + (ps * 16 + (pt & 7) * 2 + q) * 80); dst[0] = oa; dst[1] = ow; dst[2] = ok; dst[3] = ob; dst[4] = orr; }
                if ((pc >> 4) == qtr) { LAS f32x4* vd = (LAS f32x4*)(L + bo + SC_V + ps * 64 + (pc & 15) * 4); vd[0] = (f32x4){v[0], v[1], v[2], v[3]}; vd[1] = (f32x4){v[4], v[5], v[6], v[7]}; } }
            __syncthreads();
        }
    } else {
        float* YR = wsp<float>(F, WS_YRAW);
        const int l15 = lane & 15, row0 = 4 * wave + (lane >> 4);
        f32x2 Sa = {0.f, 0.f}, Sb = Sa; float yk = 0.f, yp = 0.f;
        float* yout = YR + ((size_t)b * S + l15) * 512 + h * 64 + 16 * qtr + row0;
        __syncthreads();
        for (int c = 0; c < NCH; ++c) {
            const int t0 = c * SC_CH; const int bo = (c & 1) * SC_BUF;
            const LAS unsigned char* opb = L + bo + l15 * 80; const LAS unsigned char* vb = L + bo + SC_V + row0 * 4;
            ScOp o[3];
#define SC_LD(dst, s) do { const LAS f32x4* q = (const LAS f32x4*)(opb + (s) * 1280); dst.a = q[0]; dst.w = q[1]; dst.k = q[2]; dst.b = q[3]; dst.r = q[4]; dst.v = *(const LAS float*)(vb + (s) * 64); } while (0)
            SC_LD(o[0], 0); SC_LD(o[1], 1);
#pragma unroll
            for (int s = 0; s < SC_CH; ++s) {
                if (s + 2 < SC_CH) SC_LD(o[(s + 2) % 3], s + 2);
                __builtin_amdgcn_sched_barrier(0);
                const ScOp& c_ = o[s % 3];
                const f32x2 wa = {c_.w.x, c_.w.y}, wb = {c_.w.z, c_.w.w}, ka = {c_.k.x, c_.k.y}, kb = {c_.k.z, c_.k.w}, aa = {c_.a.x, c_.a.y}, ab = {c_.a.z, c_.a.w};
                const f32x2 ba = {c_.b.x, c_.b.y}, bb = {c_.b.z, c_.b.w}, ra = {c_.r.x, c_.r.y}, rb = {c_.r.z, c_.r.w};
                const f32x2 ta = Sa * wa + ka * c_.v, tb = Sb * wb + kb * c_.v;
                const f32x2 up = Sa * aa + Sb * ab; float u = up.x + up.y;
                rowsum16x2(u, yp);
                if (s > 0 || c > 0) { if (l15 == ((s + 15) & 15)) yk = yp; if (((s + 15) & 15) == 15) yout[(size_t)(t0 + s - 16) * 512] = yk; }
                Sa = ba * u + ta; Sb = bb * u + tb;
                const f32x2 yq = Sa * ra + Sb * rb; yp = yq.x + yq.y;
                __builtin_amdgcn_sched_barrier(0);
            }
#undef SC_LD
            __syncthreads();
        }
        { float dummy = 0.f; rowsum16x2(dummy, yp); if (l15 == 15) yk = yp; yout[(size_t)(S - 16) * 512] = yk; }
    }
}

__device__ __forceinline__ void p5_rwkv_post(const Frame& F, const Args& a) {
    const int gw = F.bid * NWAVES + F.wave, NGW = F.G * NWAVES, lane = F.lane, ch = lane * 8;
    const bf16* RKV = wsp<bf16>(F, WS_RKV); const bf16* AA = wsp<bf16>(F, WS_AA); const bf16* GG = wsp<bf16>(F, WS_GG); const float* YR = wsp<float>(F, WS_YRAW); bf16* YM = wsp<bf16>(F, WS_YMIX);
    float ka[8], rk[8], lg[8], lb[8];
#pragma unroll
    for (int e = 0; e < 8; ++e) { ka[e] = kin(10)[ch + e]; rk[e] = kin(11)[ch + e]; lg[e] = kin(12)[ch + e]; lb[e] = kin(13)[ch + e]; }
    for (int t = gw; t < T; t += NGW) {
        const v4u rw = *(const v4u*)(RKV + (size_t)t * 1536 + C_R + ch), kw = *(const v4u*)(RKV + (size_t)t * 1536 + C_K + ch), vw = *(const v4u*)(RKV + (size_t)t * 1536 + C_V + ch);
        const v4u aw = *(const v4u*)(AA + (size_t)t * 512 + ch), gw4 = *(const v4u*)(GG + (size_t)t * 512 + ch);
        const f32x4 y0 = *(const f32x4*)(YR + (size_t)t * 512 + ch), y1 = *(const f32x4*)(YR + (size_t)t * 512 + ch + 4);
        float y[8] = {y0.x, y0.y, y0.z, y0.w, y1.x, y1.y, y1.z, y1.w}; float r[8], k[8], v[8], al[8], g[8];
#pragma unroll
        for (int e = 0; e < 4; ++e) { r[2 * e] = bflo(rw[e]); r[2 * e + 1] = bfhi(rw[e]); k[2 * e] = bflo(kw[e]); k[2 * e + 1] = bfhi(kw[e]); v[2 * e] = bflo(vw[e]); v[2 * e + 1] = bfhi(vw[e]);
            al[2 * e] = bflo(aw[e]); al[2 * e + 1] = bfhi(aw[e]); g[2 * e] = bflo(gw4[e]); g[2 * e + 1] = bfhi(gw4[e]); }
        float s = 0.f, bs = 0.f;
#pragma unroll
        for (int e = 0; e < 8; ++e) { s += y[e]; const float kp = k[e] * (1.0f + (al[e] - 1.0f) * ka[e]); bs += r[e] * kp * rk[e]; }
        s += __shfl_xor(s, 1); s += __shfl_xor(s, 2); s += __shfl_xor(s, 4); bs += __shfl_xor(bs, 1); bs += __shfl_xor(bs, 2); bs += __shfl_xor(bs, 4);
        const float mean = s * (1.f / 64.f); float q = 0.f;
#pragma unroll
        for (int e = 0; e < 8; ++e) { const float d = y[e] - mean; q += d * d; }
        q += __shfl_xor(q, 1); q += __shfl_xor(q, 2); q += __shfl_xor(q, 4);
        const float rstd = 1.0f / sqrtf(q * (1.f / 64.f) + GN_EPS); v4u o;
#pragma unroll
        for (int e = 0; e < 4; ++e) { const float o0 = ((y[2 * e] - mean) * rstd * lg[2 * e] + lb[2 * e] + bs * v[2 * e]) * g[2 * e], o1 = ((y[2 * e + 1] - mean) * rstd * lg[2 * e + 1] + lb[2 * e + 1] + bs * v[2 * e + 1]) * g[2 * e + 1]; o[e] = pk2(o0, o1); }
        *(v4u*)(YM + (size_t)t * 1024 + ch) = o;
    }
}

constexpr int AT_K = 0, AT_V = 24576, AT_D = 40960;
template <int TYPE> __device__ __forceinline__ void attn_naive_unit(const Frame& F, int b, int h, int qc) {
    constexpr int DK = TYPE == 0 ? 96 : 64, DH = DK / 2; constexpr float LOG2E = 1.4426950408889634f;
    const float scale = (TYPE == 0 ? 0.10206207261596577f : 0.125f) * LOG2E;
    const int tid = F.tid, half = tid & 1; const int qpos = qc * 256 + (tid >> 1); const size_t tq = (size_t)b * S + qpos;
    LAS float* Ks = (LAS float*)(F.lds + AT_K); LAS float* Vs = (LAS float*)(F.lds + AT_V); LAS float* Ds = (LAS float*)(F.lds + AT_D);
    const bf16* Qp; const bf16* Kp; const bf16* Vp; int kpitch, vpitch;
    if (TYPE == 0) { Qp = wsp<bf16>(F, WS_QM) + tq * 768 + h * 96; Kp = wsp<bf16>(F, WS_KVM) + h * 128; Vp = Kp + 64; kpitch = 1024; vpitch = 1024; }
    else if (TYPE == 1) { Qp = wsp<bf16>(F, WS_PROJ1) + tq * IN1P + h * 64; Kp = wsp<bf16>(F, WS_PROJ1) + 512 + h * 64; Vp = wsp<bf16>(F, WS_PROJ1) + 1024 + h * 64; kpitch = IN1P; vpitch = IN1P; }
    else { Qp = wsp<bf16>(F, WS_PROJ1) + tq * IN1P + 1536 + h * 64; Kp = wsp<bf16>(F, WS_PROJ1) + 2048 + h * 64; Vp = wsp<bf16>(F, WS_PROJ1) + 2560 + h * 64; kpitch = IN1P; vpitch = IN1P; }
    float q[DH];
#pragma unroll
    for (int c = 0; c < DH / 8; ++c) { const v4u w = *(const v4u*)(Qp + half * DH + 8 * c);
#pragma unroll
        for (int e = 0; e < 4; ++e) { q[8 * c + 2 * e] = bflo(w[e]); q[8 * c + 2 * e + 1] = bfhi(w[e]); } }
    if (TYPE == 0) { const float* r32 = wsp<float>(F, WS_ROPE32) + (size_t)qpos * 32;
        if (half == 1) {
#pragma unroll
            for (int i = 0; i < 16; ++i) { const float c = r32[2 * i], s = r32[2 * i + 1], x1 = q[16 + i], x2 = q[32 + i]; q[16 + i] = x1 * c - x2 * s; q[32 + i] = x2 * c + x1 * s; } } }
#pragma unroll
    for (int d = 0; d < DH; ++d) q[d] *= scale;
    float dq = 0.f; unsigned mask = 0xffffffffu;
    if (TYPE == 1) dq = wsp<float>(F, WS_DCUM)[tq * 8 + h] * LOG2E;
    if (TYPE == 2) mask = wsp<unsigned>(F, WS_SEL)[tq * 8 + h];
    float o[32];
#pragma unroll
    for (int d = 0; d < 32; ++d) o[d] = 0.f;
    float m = -1e30f, l = 0.f;
    const int nt = (qc * 256 + 256) / 64;
    const int sr = tid >> 3, sc = (tid & 7) * 8;
    for (int tile = 0; tile < nt; ++tile) {
        __syncthreads();
        { const size_t tk = (size_t)b * S + tile * 64 + sr;
          const v4u kw = *(const v4u*)(Kp + tk * kpitch + sc), vw = *(const v4u*)(Vp + tk * vpitch + sc);
#pragma unroll
          for (int e = 0; e < 4; ++e) { Ks[sr * DK + sc + 2 * e] = bflo(kw[e]); Ks[sr * DK + sc + 2 * e + 1] = bfhi(kw[e]); Vs[sr * 64 + sc + 2 * e] = bflo(vw[e]); Vs[sr * 64 + sc + 2 * e + 1] = bfhi(vw[e]); }
          if (TYPE == 0) { const v2u pw = *(const v2u*)(wsp<bf16>(F, WS_KPE) + tk * 32 + (tid & 7) * 4);
#pragma unroll
              for (int e = 0; e < 2; ++e) { Ks[sr * DK + 64 + (tid & 7) * 4 + 2 * e] = bflo(pw[e]); Ks[sr * DK + 64 + (tid & 7) * 4 + 2 * e + 1] = bfhi(pw[e]); } }
          if (TYPE == 1 && tid < 64) Ds[tid] = wsp<float>(F, WS_DCUM)[((size_t)b * S + tile * 64 + tid) * 8 + h] * LOG2E; }
        __syncthreads();
        const int kbase = tile * 64;
        const bool need = (kbase <= qpos) && ((mask >> (tile >> 2)) & 1u);
        if (need) {
#pragma unroll 1
            for (int g = 0; g < 16; ++g) {
                float s[4];
#pragma unroll
                for (int j = 0; j < 4; ++j) { const int key = g * 4 + j; float a0 = 0.f, a1 = 0.f;
#pragma unroll
                    for (int d4 = 0; d4 < DH / 4; ++d4) { const f32x4 kv = *(const LAS f32x4*)(Ks + key * DK + half * DH + 4 * d4); a0 += q[4 * d4] * kv.x + q[4 * d4 + 1] * kv.y; a1 += q[4 * d4 + 2] * kv.z + q[4 * d4 + 3] * kv.w; }
                    float acc = a0 + a1; acc += dpp_mov<0xB1>(acc);
                    if (TYPE == 1) acc += dq - Ds[key];
                    s[j] = (kbase + key <= qpos) ? acc : -1e30f; }
                const float mx = fmaxf(fmaxf(s[0], s[1]), fmaxf(s[2], s[3]));
                const float mn = fmaxf(m, mx), corr = __builtin_amdgcn_exp2f(m - mn); m = mn; l *= corr;
#pragma unroll
                for (int d = 0; d < 32; ++d) o[d] *= corr;
#pragma unroll
                for (int j = 0; j < 4; ++j) { const float p = __builtin_amdgcn_exp2f(s[j] - mn); l += p; const int key = g * 4 + j;
#pragma unroll
                    for (int d4 = 0; d4 < 8; ++d4) { const f32x4 vv = *(const LAS f32x4*)(Vs + key * 64 + half * 32 + 4 * d4); o[4 * d4] += p * vv.x; o[4 * d4 + 1] += p * vv.y; o[4 * d4 + 2] += p * vv.z; o[4 * d4 + 3] += p * vv.w; } }
            }
        }
    }
    const float il = 1.0f / l; bf16* Op = wsp<bf16>(F, WS_YMIX) + tq * 1024 + (TYPE == 1 ? 0 : 512) + h * 64 + half * 32;
#pragma unroll
    for (int c = 0; c < 4; ++c) { v4u w;
#pragma unroll
        for (int e = 0; e < 4; ++e) w[e] = pk2(o[8 * c + 2 * e] * il, o[8 * c + 2 * e + 1] * il);
        *(v4u*)(Op + 8 * c) = w; }
}
template <int TYPE> __device__ __forceinline__ void attn_naive_phase(const Frame& F, int first, int nblk) {
    const int me = F.bid - first; if (me < 0 || me >= nblk) return;
    for (int i = me; i < NB * NH * 32; i += nblk) { const int qc = 31 - i / (NB * NH), bh = i % (NB * NH); attn_naive_unit<TYPE>(F, bh >> 3, bh & 7, qc); }
}

typedef short bf16x8_t __attribute__((ext_vector_type(8)));
typedef short s16x4_t __attribute__((ext_vector_type(4)));
typedef float f32x16_t __attribute__((ext_vector_type(16)));
__device__ __forceinline__ unsigned cvtpk(float lo, float hi) { unsigned r; asm volatile("v_cvt_pk_bf16_f32 %0, %1, %2" : "=v"(r) : "v"(lo), "v"(hi)); return r; }
__device__ __forceinline__ int crow(int r, int hi) { return (r & 3) + 8 * (r >> 2) + 4 * hi; }
template <int TYPE> __device__ __forceinline__ void attn_unit(const Frame& F, int b, int h, int qb) {
    constexpr int DK = TYPE == 0 ? 96 : 64, NC = DK / 16, KSTR = 144, PSTR = 80, VSTR = 192, KBUF = 64 * KSTR + (TYPE == 0 ? 64 * PSTR : 0), VBUF = 64 * VSTR;
    constexpr int NSL = 4, AK = 0, AV = NSL * KBUF, AD = NSL * KBUF + NSL * VBUF;
    constexpr float LOG2E = 1.4426950408889634f; const float scale = (TYPE == 0 ? 0.10206207261596577f : 0.125f) * LOG2E;
    int tid_ = F.tid; asm volatile("" : "+v"(tid_));
    const int tid = tid_, lane = tid & 63, wave = __builtin_amdgcn_readfirstlane(tid >> 6), r32 = lane & 31, hi = lane >> 5;
    const int q0 = qb * 256, qrel = wave * 32 + r32; const size_t tq = (size_t)b * S + q0 + qrel;
    LAS unsigned char* L = F.lds;
    const bf16* Qp; const bf16* Kp; const bf16* Vp; int kvpitch;
    if (TYPE == 0) { Qp = wsp<bf16>(F, WS_QM) + tq * 768 + h * 96; Kp = wsp<bf16>(F, WS_KVM) + h * 128; Vp = Kp + 64; kvpitch = 1024; }
    else if (TYPE == 1) { Qp = wsp<bf16>(F, WS_PROJ1) + tq * IN1P + h * 64; Kp = wsp<bf16>(F, WS_PROJ1) + 512 + h * 64; Vp = wsp<bf16>(F, WS_PROJ1) + 1024 + h * 64; kvpitch = IN1P; }
    else { Qp = wsp<bf16>(F, WS_PROJ1) + tq * IN1P + 1536 + h * 64; Kp = wsp<bf16>(F, WS_PROJ1) + 2048 + h * 64; Vp = wsp<bf16>(F, WS_PROJ1) + 2560 + h * 64; kvpitch = IN1P; }
    bf16x8_t qf[NC]; unsigned selmask = 0xffffffffu;
    { float qv[NC][8];
#pragma unroll
      for (int c = 0; c < NC; ++c) { const v4u w = *(const v4u*)(Qp + 16 * c + 8 * hi);
#pragma unroll
          for (int e = 0; e < 4; ++e) { qv[c][2 * e] = bflo(w[e]); qv[c][2 * e + 1] = bfhi(w[e]); } }
      if (TYPE == 0) { const float* rt = wsp<float>(F, WS_ROPE32) + (size_t)(q0 + qrel) * 32;
#pragma unroll
          for (int j = 0; j < 8; ++j) { const float c = rt[2 * (8 * hi + j)], s = rt[2 * (8 * hi + j) + 1], x1 = qv[NC - 2][j], x2 = qv[NC - 1][j]; qv[NC - 2][j] = x1 * c - x2 * s; qv[NC - 1][j] = x2 * c + x1 * s; } }
      if (TYPE == 2) {
          const float* km = wsp<float>(F, WS_KMEAN) + ((size_t)b * NH + h) * MOBA_NB * 64; LAS float* KL = (LAS float*)(F.lds + 120 * 1024);
          __syncthreads();
          for (int i = tid; i < qb * 64; i += NTHR) KL[i] = km[i];
          __syncthreads();
          float v0 = -INFINITY, v1 = -INFINITY, v2 = -INFINITY; int i0 = -1, i1 = -1, i2 = -1;
          for (int n = 0; n < qb; ++n) { float g = 0.f;
#pragma unroll
              for (int c = 0; c < NC; ++c) { const f32x4 ka = *(const LAS f32x4*)(KL + n * 64 + 16 * c + 8 * hi), kb2 = *(const LAS f32x4*)(KL + n * 64 + 16 * c + 8 * hi + 4);
                  g += (qv[c][0] * ka.x + qv[c][1] * ka.y) + (qv[c][2] * ka.z + qv[c][3] * ka.w) + (qv[c][4] * kb2.x + qv[c][5] * kb2.y) + (qv[c][6] * kb2.z + qv[c][7] * kb2.w); }
              g += __shfl_xor(g, 32);
              if (g > v0) { v2 = v1; i2 = i1; v1 = v0; i1 = i0; v0 = g; i0 = n; } else if (g > v1) { v2 = v1; i2 = i1; v1 = g; i1 = n; } else if (g > v2) { v2 = g; i2 = n; } }
          selmask = 1u << qb; if (i0 >= 0) selmask |= 1u << i0; if (i1 >= 0) selmask |= 1u << i1; if (i2 >= 0) selmask |= 1u << i2; }
#pragma unroll
      for (int c = 0; c < NC; ++c) { v4u w;
#pragma unroll
          for (int e = 0; e < 4; ++e) w[e] = cvtpk(qv[c][2 * e] * scale, qv[c][2 * e + 1] * scale);
          qf[c] = __builtin_bit_cast(bf16x8_t, w); } }
    float dq = 0.f; unsigned mask = selmask;
    if (TYPE == 1) dq = wsp<float>(F, WS_DCUM)[tq * 8 + h] * LOG2E;
    f32x16_t o0 = {}, o1 = {}; float m = 0.f, l = 0.f;
    const int nt = 4 * qb + 4;
    const int sr = tid >> 3, sc = tid & 7;
    const bf16* kg = Kp + ((size_t)b * S + sr) * kvpitch + sc * 8; const bf16* vg = Vp + ((size_t)b * S + sr) * kvpitch + sc * 8;
    const bf16* pg = wsp<bf16>(F, WS_KPE) + ((size_t)b * S + sr) * 32 + sc * 4; const float* dg = wsp<float>(F, WS_DCUM) + ((size_t)b * S + tid) * 8 + h;
    v4u kreg, vreg; v2u preg = {0u, 0u}; float dreg = 0.f;
#define AT_LOAD(s_) do { const int i_ = nt - 1 - (s_);     \
        kreg = *(const v4u*)(kg + (size_t)i_ * 64 * kvpitch); vreg = *(const v4u*)(vg + (size_t)i_ * 64 * kvpitch); \
        if (TYPE == 0) preg = *(const v2u*)(pg + (size_t)i_ * 64 * 32); if (TYPE == 1 && tid < 64) dreg = dg[(size_t)i_ * 64 * 8] * LOG2E; } while (0)
#define AT_WRITE(sl) do { *(LAS v4u*)(L + AK + (sl) * KBUF + sr * KSTR + sc * 16) = kreg; *(LAS v4u*)(L + AV + (sl) * VBUF + sr * VSTR + sc * 16) = vreg; \
        if (TYPE == 0) *(LAS v2u*)(L + AK + (sl) * KBUF + 64 * KSTR + sr * PSTR + sc * 8) = preg; if (TYPE == 1 && tid < 64) *(LAS float*)(L + AD + (sl) * 256 + tid * 4) = dreg; } while (0)
    const int kfoff = r32 * KSTR + hi * 16;
    const int vtoff = (4 * hi + ((lane & 15) >> 2)) * VSTR + (((lane >> 4) & 1) * 16 + (lane & 3) * 4) * 2;
#define AT_KF(sl) do { kslot = (sl); const LAS unsigned char* kb = L + AK + (sl) * KBUF + kfoff; \
        _Pragma("unroll") for (int c = 0; c < 4; ++c) { kf0[c] = *(const LAS bf16x8_t*)(kb + c * 32); kf1[c] = *(const LAS bf16x8_t*)(kb + 32 * KSTR + c * 32); } } while (0)
#define AT_CINIT(S0, S1, i, sl) do { \
        if (TYPE == 1) { const LAS float* Dk = (const LAS float*)(L + AD + (sl) * 256); const float dqm = dq - m; \
            _Pragma("unroll") for (int g = 0; g < 4; ++g) { const f32x4 d0 = *(const LAS f32x4*)(Dk + 8 * g + 4 * hi), d1 = *(const LAS f32x4*)(Dk + 32 + 8 * g + 4 * hi); \
                _Pragma("unroll") for (int e = 0; e < 4; ++e) { S0[4 * g + e] = dqm - d0[e]; S1[4 * g + e] = dqm - d1[e]; } } } \
        else { float bm = -m; if (TYPE == 2) bm = (((mask >> ((i) >> 2)) & 1u) ? 0.f : -1e30f) - m; \
            _Pragma("unroll") for (int r = 0; r < 16; ++r) { S0[r] = bm; S1[r] = bm; } } } while (0)
#define AT_QKM(S0, S1) do { _Pragma("unroll") for (int c = 0; c < 4; ++c) { S0 = __builtin_amdgcn_mfma_f32_32x32x16_bf16(kf0[c], qf[c], S0, 0, 0, 0); S1 = __builtin_amdgcn_mfma_f32_32x32x16_bf16(kf1[c], qf[c], S1, 0, 0, 0); } \
        if (TYPE == 0) { const LAS unsigned char* pb = L + AK + kslot * KBUF + 64 * KSTR + r32 * PSTR + hi * 16;     \
            _Pragma("unroll") for (int c = 0; c < 2; ++c) { const bf16x8_t k0 = *(const LAS bf16x8_t*)(pb + c * 32), k1 = *(const LAS bf16x8_t*)(pb + 32 * PSTR + c * 32); \
                S0 = __builtin_amdgcn_mfma_f32_32x32x16_bf16(k0, qf[4 + c], S0, 0, 0, 0); S1 = __builtin_amdgcn_mfma_f32_32x32x16_bf16(k1, qf[4 + c], S1, 0, 0, 0); } } } while (0)
    bf16x8_t kf0[4], kf1[4]; int kslot = 0;
    const bool grpB = wave >= 4;
    float qn = 0.f, rmax = -1e30f; LAS float* PK = (LAS float*)(L + 118 * 1024); volatile LAS unsigned* PF = (volatile LAS unsigned*)(L + 119 * 1024);
    if (TYPE == 1) {
        if (wave == 0) { const float* kn = wsp<float>(F, WS_KMEAN) + 65536 + ((size_t)b * NH + h) * 128; float v0 = 2 * lane < nt ? kn[2 * lane] : 0.f, v1 = fmaxf(v0, 2 * lane + 1 < nt ? kn[2 * lane + 1] : 0.f); float sc = v1;
#pragma unroll
            for (int o_ = 1; o_ < 64; o_ <<= 1) { const float n_ = __shfl_up(sc, o_); if (lane >= o_) sc = fmaxf(sc, n_); }
            const float prev = __shfl_up(sc, 1); PK[2 * lane] = fmaxf(lane > 0 ? prev : 0.f, v0); PK[2 * lane + 1] = sc; }
        float s2 = 0.f;
#pragma unroll
        for (int c = 0; c < NC; ++c) { const v4u w_ = __builtin_bit_cast(v4u, qf[c]);
#pragma unroll
            for (int e = 0; e < 4; ++e) { const float a_ = bflo(w_[e]), b_ = bfhi(w_[e]); s2 += a_ * a_ + b_ * b_; } }
        s2 += __shfl_xor(s2, 32); qn = sqrtf(s2) * 1.02f; }
    __syncthreads();
    AT_LOAD(0); AT_WRITE(0); AT_LOAD(1); AT_WRITE(1); AT_LOAD(2); AT_WRITE(2);
    __syncthreads();
    f32x16_t sc0, sc1, sn0, sn1;
    AT_KF(0); AT_CINIT(sc0, sc1, nt - 1, 0); AT_QKM(sc0, sc1);
    int s_cur = 0, s_nxt = 1, s_n2 = 2, s_far = 3;
    if (grpB) __syncthreads();
    for (int i = 0; i < nt; ++i) {
        if (TYPE == 1 && i > 0) { unsigned any = 0u;
#pragma unroll
            for (int w_ = 0; w_ < 8; ++w_) any |= PF[((i - 1) & 1) * 8 + w_];
            if (any == 0u) break; }
        if (i + 3 < nt) AT_LOAD(i + 3);
        AT_KF(s_nxt);
        s16x4_t va[4][2], vc[4][2];
        { const LAS unsigned char* vb = L + AV + s_cur * VBUF + vtoff;
#pragma unroll
          for (int ts = 0; ts < 4; ++ts)
#pragma unroll
              for (int db = 0; db < 2; ++db) { va[ts][db] = __builtin_bit_cast(s16x4_t, __builtin_amdgcn_ds_read_tr16_b64_v4i16((LAS s16x4_t*)(vb + ts * 16 * VSTR + db * 64)));
                  vc[ts][db] = __builtin_bit_cast(s16x4_t, __builtin_amdgcn_ds_read_tr16_b64_v4i16((LAS s16x4_t*)(vb + (ts * 16 + 8) * VSTR + db * 64))); } }
        AT_CINIT(sn0, sn1, nt - 2 - i, s_nxt);
        const int jb = 3 - i;
        if (jb >= 0 && 64 * jb + 63 > 32 * wave) {
#pragma unroll
            for (int r = 0; r < 16; ++r) { const int kv = 64 * jb + crow(r, hi); if (kv > qrel) sc0[r] = -1e30f; if (kv + 32 > qrel) sc1[r] = -1e30f; } }
        float mxa = fmaxf(fmaxf(sc0[0], sc0[1]), fmaxf(sc1[0], sc1[1])), mxb = fmaxf(fmaxf(sc0[2], sc0[3]), fmaxf(sc1[2], sc1[3]));
        float mxc = fmaxf(fmaxf(sc0[4], sc0[5]), fmaxf(sc1[4], sc1[5])), mxd = fmaxf(fmaxf(sc0[6], sc0[7]), fmaxf(sc1[6], sc1[7]));
#pragma unroll
        for (int r = 8; r < 16; r += 4) { mxa = fmaxf(mxa, fmaxf(sc0[r], sc1[r])); mxb = fmaxf(mxb, fmaxf(sc0[r + 1], sc1[r + 1])); mxc = fmaxf(mxc, fmaxf(sc0[r + 2], sc1[r + 2])); mxd = fmaxf(mxd, fmaxf(sc0[r + 3], sc1[r + 3])); }
        float mx = fmaxf(fmaxf(mxa, mxb), fmaxf(mxc, mxd));
        { auto rr = __builtin_amdgcn_permlane32_swap(__builtin_bit_cast(unsigned, mx), __builtin_bit_cast(unsigned, mx), false, false); mx = fmaxf(__builtin_bit_cast(float, rr[0]), __builtin_bit_cast(float, rr[1])); }
        if (TYPE == 1) rmax = fmaxf(rmax, mx);
        if (__builtin_expect(__ballot(mx > 8.0f) != 0ull, 0)) {
            const float dl = fmaxf(mx, 0.f), corr = __builtin_amdgcn_exp2f(-dl); m += dl; l *= corr; rmax -= dl;
#pragma unroll
            for (int r = 0; r < 16; ++r) { sc0[r] -= dl; sc1[r] -= dl; sn0[r] -= dl; sn1[r] -= dl; o0[r] *= corr; o1[r] *= corr; } }
#pragma unroll
        for (int r = 0; r < 16; ++r) { sc0[r] = __builtin_amdgcn_exp2f(sc0[r]); sc1[r] = __builtin_amdgcn_exp2f(sc1[r]); }
        float la = 0.f, lb = 0.f, lc = 0.f, ld = 0.f;
#pragma unroll
        for (int r = 0; r < 16; r += 2) { la += sc0[r]; lb += sc1[r]; lc += sc0[r + 1]; ld += sc1[r + 1]; }
        l += (la + lb) + (lc + ld);
        if (TYPE == 1) { const int tn = nt - 2 - i;
            bool need = false;
            if (tn >= 0) { const float dlast = *(const LAS float*)(L + AD + s_nxt * 256 + 63 * 4); need = (qn * PK[tn] + (dq - dlast) - m - rmax) > -40.0f; }
            const bool wn = __ballot(need) != 0ull; if (lane == 0) PF[(i & 1) * 8 + wave] = wn ? 1u : 0u; }
        __syncthreads();
        AT_QKM(sn0, sn1);
#pragma unroll
        for (int ts = 0; ts < 4; ++ts) { v4u pw; const int rb = 8 * (ts & 1);
            if (ts < 2) { pw.x = cvtpk(sc0[rb], sc0[rb + 1]); pw.y = cvtpk(sc0[rb + 2], sc0[rb + 3]); pw.z = cvtpk(sc0[rb + 4], sc0[rb + 5]); pw.w = cvtpk(sc0[rb + 6], sc0[rb + 7]); }
            else { pw.x = cvtpk(sc1[rb], sc1[rb + 1]); pw.y = cvtpk(sc1[rb + 2], sc1[rb + 3]); pw.z = cvtpk(sc1[rb + 4], sc1[rb + 5]); pw.w = cvtpk(sc1[rb + 6], sc1[rb + 7]); }
            const bf16x8_t pf = __builtin_bit_cast(bf16x8_t, pw);
            const bf16x8_t vf0 = (bf16x8_t){va[ts][0][0], va[ts][0][1], va[ts][0][2], va[ts][0][3], vc[ts][0][0], vc[ts][0][1], vc[ts][0][2], vc[ts][0][3]};
            const bf16x8_t vf1 = (bf16x8_t){va[ts][1][0], va[ts][1][1], va[ts][1][2], va[ts][1][3], vc[ts][1][0], vc[ts][1][1], vc[ts][1][2], vc[ts][1][3]};
            o0 = __builtin_amdgcn_mfma_f32_32x32x16_bf16(vf0, pf, o0, 0, 0, 0); o1 = __builtin_amdgcn_mfma_f32_32x32x16_bf16(vf1, pf, o1, 0, 0, 0); }
        if (i + 3 < nt) AT_WRITE(s_far);
        __syncthreads();
        sc0 = sn0; sc1 = sn1; { const int t_ = s_cur; s_cur = s_nxt; s_nxt = s_n2; s_n2 = s_far; s_far = t_; }
    }
    if (!grpB) __syncthreads();
#undef AT_KF
#undef AT_CINIT
#undef AT_QKM
#undef AT_LOAD
#undef AT_WRITE
#undef AT_QK
    l += __shfl_xor(l, 32); const float il = 1.0f / l;
    bf16* Op = wsp<bf16>(F, WS_YMIX) + tq * 1024 + (TYPE == 1 ? 0 : 512) + h * 64 + 4 * hi;
#pragma unroll
    for (int g = 0; g < 4; ++g) { v2u w0, w1; w0.x = cvtpk(o0[4 * g] * il, o0[4 * g + 1] * il); w0.y = cvtpk(o0[4 * g + 2] * il, o0[4 * g + 3] * il); w1.x = cvtpk(o1[4 * g] * il, o1[4 * g + 1] * il); w1.y = cvtpk(o1[4 * g + 2] * il, o1[4 * g + 3] * il);
        *(v2u*)(Op + 8 * g) = w0; *(v2u*)(Op + 32 + 8 * g) = w1; }
}
template <int TA, int TB> __device__ __forceinline__ void attn_queue_phase(const Frame& F, gu32* ctr) {
    constexpr int NT = TB >= 0 ? 2 : 1; volatile LAS unsigned* slot = (volatile LAS unsigned*)(F.lds + MISC_OFF + 64);
    constexpr int NU = NB * NH * 32 * NT; unsigned tkt = 0u; bool have = false;
    for (;;) {
        __syncthreads();
        if (F.tid == 0) *slot = have ? tkt : __hip_atomic_fetch_add(ctr, 1u, RLX_AGENT);
        __syncthreads();
        const int u = (int)__builtin_amdgcn_readfirstlane(*slot);
        if (u >= NU) break;
        have = u + 2 * F.G < NU; if (have && F.tid == 0) tkt = __hip_atomic_fetch_add(ctr, 1u, RLX_AGENT);
        const int qb = 31 - u / (NB * NH * NT), rest = u % (NB * NH * NT), ty = rest / (NB * NH), bh = rest % (NB * NH);
        if (NT == 1 || ty == 0) attn_unit<TA>(F, bh >> 3, bh & 7, qb); else attn_unit<(TB >= 0 ? TB : TA)>(F, bh >> 3, bh & 7, qb);
    }
}

constexpr int CK_P = 65, CK_PN = 68, CK_SLOT = 17408;
constexpr int CK_ITEMS = NB * NH * (S / 64);
#ifndef CK_BF16
#define CK_BF16 1
#endif
template <int XSR, int XSC, int YSR, int YSC> __device__ __forceinline__ void mm32(f32x16_t& acc, const LAS float* xp, const LAS float* yp, int lane) {
#if CK_BF16
    const int i = lane & 31, h8 = (lane >> 5) * 8; const LAS float* xa = xp + i * XSR + h8 * XSC; const LAS float* yb = yp + h8 * YSR + i * YSC;
#pragma unroll
    for (int ks = 0; ks < 4; ++ks) { float a[8], b[8];
#pragma unroll
        for (int j = 0; j < 8; ++j) { a[j] = xa[(16 * ks + j) * XSC]; b[j] = yb[(16 * ks + j) * YSR]; }
        v4u aw, bw;
#pragma unroll
        for (int e = 0; e < 4; ++e) { aw[e] = cvtpk(a[2 * e], a[2 * e + 1]); bw[e] = cvtpk(b[2 * e], b[2 * e + 1]); }
        acc = __builtin_amdgcn_mfma_f32_32x32x16_bf16(__builtin_bit_cast(bf16x8_t, aw), __builtin_bit_cast(bf16x8_t, bw), acc, 0, 0, 0); }
#else
    const int i = lane & 31, kk = lane >> 5; const LAS float* xa = xp + i * XSR + kk * XSC; const LAS float* yb = yp + kk * YSR + i * YSC;
#pragma unroll
    for (int s = 0; s < 32; ++s) acc = __builtin_amdgcn_mfma_f32_32x32x2f32(xa[2 * s * XSC], yb[2 * s * YSR], acc, 0, 0, 0);
#endif
}
struct CkRaw { v4u rw, kw, vw, ew, aw; };
__device__ __forceinline__ void ck_load(CkRaw& q, const bf16* RKV, const bf16* EW, const bf16* AA, size_t tok, int ch) {
    q.rw = *(const v4u*)(RKV + tok * 1536 + C_R + ch); q.kw = *(const v4u*)(RKV + tok * 1536 + C_K + ch); q.vw = *(const v4u*)(RKV + tok * 1536 + C_V + ch);
    q.ew = *(const v4u*)(EW + tok * 512 + ch); q.aw = *(const v4u*)(AA + tok * 512 + ch);
}
constexpr int CK_TBL = 7 * CK_SLOT + 1024;
__device__ __forceinline__ void ck_raw(const CkRaw& q, int ch, float (&rr)[8], float (&an)[8], float (&bb)[8], float (&kp)[8], float (&vv)[8], float (&ew)[8], const LAS float* ktab) {
    float kx[8], al[8], kk[8], ss = 0.f;
#pragma unroll
    for (int e = 0; e < 4; ++e) { rr[2 * e] = bflo(q.rw[e]); rr[2 * e + 1] = bfhi(q.rw[e]); kx[2 * e] = bflo(q.kw[e]); kx[2 * e + 1] = bfhi(q.kw[e]); vv[2 * e] = bflo(q.vw[e]); vv[2 * e + 1] = bfhi(q.vw[e]);
        ew[2 * e] = bflo(q.ew[e]); ew[2 * e + 1] = bfhi(q.ew[e]); al[2 * e] = bflo(q.aw[e]); al[2 * e + 1] = bfhi(q.aw[e]); }
    const LAS f32x4* kt4 = (const LAS f32x4*)(ktab + ch); const f32x4 kk0 = kt4[0], kk1 = kt4[1], ka0 = kt4[128], ka1 = kt4[129];
    const float kks[8] = {kk0.x, kk0.y, kk0.z, kk0.w, kk1.x, kk1.y, kk1.z, kk1.w}, kas[8] = {ka0.x, ka0.y, ka0.z, ka0.w, ka1.x, ka1.y, ka1.z, ka1.w};
#pragma unroll
    for (int e = 0; e < 8; ++e) { kk[e] = kx[e] * kks[e]; ss += kk[e] * kk[e]; }
    ss = sum8(ss); const float inv = 1.0f / fmaxf(sqrtf(ss), 1e-12f);
#pragma unroll
    for (int e = 0; e < 8; ++e) { const float kn = kk[e] * inv; an[e] = -kn; bb[e] = kn * al[e]; kp[e] = kx[e] * (1.0f + (al[e] - 1.0f) * kas[e]); }
}
__device__ __forceinline__ void rwkv_chunk_prep(const Frame& F, int item, const CkRaw& raw, CkRaw& nxt, int next_item) {
    const int c = item & 127, h = (item >> 7) & 7, b = item >> 10;
    int tid_ = F.tid; asm volatile("" : "+v"(tid_)); const int tid = tid_, lane = tid & 63, wave = __builtin_amdgcn_readfirstlane(tid >> 6), hi = lane >> 5, col = lane & 31;
    LAS float* R0 = (LAS float*)(F.lds); LAS float* R1 = (LAS float*)(F.lds + CK_SLOT); LAS float* R2 = (LAS float*)(F.lds + 2 * CK_SLOT); LAS float* R3 = (LAS float*)(F.lds + 3 * CK_SLOT);
    LAS float* R4 = (LAS float*)(F.lds + 4 * CK_SLOT); LAS float* R5 = (LAS float*)(F.lds + 5 * CK_SLOT); LAS float* R6 = (LAS float*)(F.lds + 6 * CK_SLOT); LAS float* GC = (LAS float*)(F.lds + 7 * CK_SLOT);
    const bf16* RKV = wsp<bf16>(F, WS_RKV); const bf16* EW = wsp<bf16>(F, WS_EW); const bf16* AA = wsp<bf16>(F, WS_AA);
    float* GZ = F.H + (size_t)item * 8192; bf16* QW = wsp<bf16>(F, WS_YRAW) + (size_t)item * 8192;
    const int t = tid >> 3, k8 = (tid & 7) * 8, ch = h * 64 + k8; const size_t tok = (size_t)b * S + c * 64 + t;
    { float rr[8], an[8], bb[8], kp[8], vv[8], ew[8]; ck_raw(raw, ch, rr, an, bb, kp, vv, ew, (const LAS float*)(F.lds + CK_TBL));
      __syncthreads();
      asm volatile("" :: "v"(raw.rw), "v"(raw.kw), "v"(raw.vw), "v"(raw.ew), "v"(raw.aw));
      if (next_item < CK_ITEMS) { const int c2 = next_item & 127, h2 = (next_item >> 7) & 7, b2 = next_item >> 10; ck_load(nxt, RKV, EW, AA, (size_t)b2 * S + c2 * 64 + t, h2 * 64 + k8); }
      { float cs[8]; const int tl = lane >> 3;
#pragma unroll
        for (int e = 0; e < 8; ++e) { float v = ew[e]; float n = __shfl_up(v, 8); if (tl >= 1) v += n; n = __shfl_up(v, 16); if (tl >= 2) v += n; n = __shfl_up(v, 32); if (tl >= 4) v += n; cs[e] = v; }
        if (tl == 7) {
#pragma unroll
            for (int e = 0; e < 8; ++e) R5[wave * 64 + k8 + e] = cs[e]; }
        __syncthreads();
        float off[8];
#pragma unroll
        for (int e = 0; e < 8; ++e) off[e] = 0.f;
        for (int w = 0; w < wave; ++w) {
#pragma unroll
            for (int e = 0; e < 8; ++e) off[e] += R5[w * 64 + k8 + e]; }
#pragma unroll
        for (int e = 0; e < 8; ++e) { cs[e] += off[e]; R6[t * CK_P + k8 + e] = cs[e]; }
        if (t == 63) {
#pragma unroll
            for (int e = 0; e < 8; ++e) { GC[k8 + e] = __expf(-cs[e]); GC[64 + k8 + e] = cs[e]; } } }
      __syncthreads();
#pragma unroll
      for (int e = 0; e < 8; ++e) { const float cl = R6[t * CK_P + k8 + e]; const float ep = __expf(cl), em = __expf(-cl), eme = __expf(-(cl - ew[e]));
          R0[t * CK_P + k8 + e] = an[e] * eme; R2[t * CK_P + k8 + e] = rr[e] * em; R3[t * CK_P + k8 + e] = bb[e] * ep; R4[t * CK_P + k8 + e] = kp[e] * ep; } }
    __syncthreads();
    const int bi = (wave >> 1) & 1, bj = wave & 1;
    { f32x16_t acc = {}; mm32<CK_P, 1, 1, CK_P>(acc, (wave < 4 ? R3 : R4) + bi * 32 * CK_P, R0 + bj * 32 * CK_P, lane);
#pragma unroll
      for (int r = 0; r < 16; ++r) { const int i = bi * 32 + crow(r, hi), tt = bj * 32 + col; (wave < 4 ? R5 + i * CK_PN : R1 + i * CK_P)[tt] = i < tt ? acc[r] : 0.f; } }
    __syncthreads();
    if (wave >= 4) { const int mat = (wave - 4) >> 1, ib = (wave - 4) & 1; LAS float* X = mat == 0 ? R3 : R4; f32x16_t a0 = {}, a1 = {};
        mm32<CK_P, 1, 1, CK_P>(a0, X + ib * 32 * CK_P, R2, lane); mm32<CK_P, 1, 1, CK_P>(a1, X + ib * 32 * CK_P, R2 + 32 * CK_P, lane);
#pragma unroll
        for (int r = 0; r < 16; ++r) { const int i = ib * 32 + crow(r, hi); X[i * CK_P + col] = i <= col ? a0[r] : 0.f; X[i * CK_P + 32 + col] = i <= 32 + col ? a1[r] : 0.f; }
    } else {
        const int row = tid >> 1, hf = tid & 1; LAS float* xb = row < 64 ? R0 + row : R1 + (row - 64) * CK_P; const int xs = row < 64 ? CK_P : 1;
#pragma unroll 1
        for (int B = 0; B < 4; ++B) { float acc[8];
#pragma unroll
            for (int j = 0; j < 8; ++j) acc[j] = xb[(16 * B + 8 * hf + j) * xs];
#pragma unroll 8
            for (int i = 0; i < 16 * B; ++i) { const float xi = xb[i * xs]; const LAS f32x4* nr = (const LAS f32x4*)(R5 + i * CK_PN + 16 * B + 8 * hf); const f32x4 n0 = nr[0], n1 = nr[1];
                acc[0] += xi * n0.x; acc[1] += xi * n0.y; acc[2] += xi * n0.z; acc[3] += xi * n0.w; acc[4] += xi * n1.x; acc[5] += xi * n1.y; acc[6] += xi * n1.z; acc[7] += xi * n1.w; }
#pragma unroll
            for (int jj = 0; jj < 15; ++jj) { const float own = acc[jj & 7], oth = dpp_mov<0xB1>(own); const float xj = hf == (jj >> 3) ? own : oth;
                const LAS f32x4* nr = (const LAS f32x4*)(R5 + (16 * B + jj) * CK_PN + 16 * B + 8 * hf); const f32x4 n0 = nr[0], n1 = nr[1];
                acc[0] += xj * n0.x; acc[1] += xj * n0.y; acc[2] += xj * n0.z; acc[3] += xj * n0.w; acc[4] += xj * n1.x; acc[5] += xj * n1.y; acc[6] += xj * n1.z; acc[7] += xj * n1.w; }
#pragma unroll
            for (int j = 0; j < 8; ++j) xb[(16 * B + 8 * hf + j) * xs] = acc[j]; }
    }
    __syncthreads();
    if (wave < 4) { f32x16_t acc;
#pragma unroll
        for (int r = 0; r < 16; ++r) acc[r] = R2[(bj * 32 + col) * CK_P + bi * 32 + crow(r, hi)];
        mm32<1, CK_P, CK_P, 1>(acc, R0 + bi * 32, R3 + bj * 32, lane);
#pragma unroll
        for (int r = 0; r < 16; ++r) QW[(bi * 32 + crow(r, hi)) * 64 + bj * 32 + col] = (bf16)f2bf(acc[r]);
    } else { f32x16_t acc;
#pragma unroll
        for (int r = 0; r < 16; ++r) acc[r] = R4[(bi * 32 + crow(r, hi)) * CK_P + bj * 32 + col];
        mm32<CK_P, 1, CK_P, 1>(acc, R1 + bi * 32 * CK_P, R3 + bj * 32, lane);
#pragma unroll
        for (int r = 0; r < 16; ++r) R4[(bi * 32 + crow(r, hi)) * CK_P + bj * 32 + col] = acc[r]; }
    __syncthreads();
    { float rr[8], an[8], bb[8], kp[8], vv[8], ew[8]; ck_raw(raw, ch, rr, an, bb, kp, vv, ew, (const LAS float*)(F.lds + CK_TBL));
#pragma unroll
      for (int e = 0; e < 8; ++e) { const float eh = __expf(-(GC[64 + k8 + e] - R6[t * CK_P + k8 + e])); R2[t * CK_P + k8 + e] = bb[e] * eh; R5[t * CK_P + k8 + e] = kp[e] * eh; R3[t * CK_P + k8 + e] = vv[e]; } }
    __syncthreads();
    if (wave < 4) { f32x16_t acc;
#pragma unroll
        for (int r = 0; r < 16; ++r) acc[r] = 0.f;
        mm32<1, CK_P, CK_P, 1>(acc, R0 + bi * 32, R2 + bj * 32, lane);
        if (wave == 0) wsp<float>(F, WS_SSQ)[(size_t)item * 64 + lane] = GC[lane];
#pragma unroll
        for (int r = 0; r < 16; ++r) GZ[(bi * 32 + crow(r, hi)) * 64 + bj * 32 + col] = acc[r];
    } else { f32x16_t acc;
#pragma unroll
        for (int r = 0; r < 16; ++r) acc[r] = R5[(bi * 32 + crow(r, hi)) * CK_P + bj * 32 + col];
        mm32<CK_P, 1, CK_P, 1>(acc, R1 + bi * 32 * CK_P, R2 + bj * 32, lane);
#pragma unroll
        for (int r = 0; r < 16; ++r) R5[(bi * 32 + crow(r, hi)) * CK_P + bj * 32 + col] = acc[r]; }
    __syncthreads();
    { f32x16_t acc = {}; mm32<1, CK_P, CK_P, 1>(acc, R3 + bi * 32, (wave < 4 ? R5 : R4) + bj * 32, lane);
      if (wave < 4) {
#pragma unroll
          for (int r = 0; r < 16; ++r) GZ[4096 + (bi * 32 + crow(r, hi)) * 64 + bj * 32 + col] = acc[r];
      } else {
#pragma unroll
          for (int r = 0; r < 16; ++r) QW[4096 + (bi * 32 + crow(r, hi)) * 64 + bj * 32 + col] = (bf16)f2bf(acc[r]); } }
}
__device__ __forceinline__ void rwkv_chunk_scan(const Frame& F, int bh) {
    const int b = bh >> 3, h = bh & 7;
    int tid_ = F.tid; asm volatile("" : "+v"(tid_)); const int tid = tid_, lane = tid & 63, wave = __builtin_amdgcn_readfirstlane(tid >> 6), hi = lane >> 5, col = lane & 31;
    LAS float* SA = (LAS float*)(F.lds); LAS float* SB = (LAS float*)(F.lds + CK_SLOT); LAS float* GL = (LAS float*)(F.lds + 2 * CK_SLOT); LAS float* QL = (LAS float*)(F.lds + 3 * CK_SLOT); LAS float* YL = (LAS float*)(F.lds + 4 * CK_SLOT);
    const bf16* RKV = wsp<bf16>(F, WS_RKV); const bf16* AA = wsp<bf16>(F, WS_AA); const bf16* GG = wsp<bf16>(F, WS_GG); bf16* YM = wsp<bf16>(F, WS_YMIX);
    const int bi = (wave >> 1) & 1, bj = wave & 1;
    __syncthreads();
    for (int i = tid; i < 64 * CK_P; i += NTHR) SA[i] = 0.f;
    const int pt = tid >> 3, pk = (tid & 7) * 8, pch = h * 64 + pk;
    float ka[8], rk[8], lg[8], lb[8];
#pragma unroll
    for (int e = 0; e < 8; ++e) { ka[e] = kin(10)[pch + e]; rk[e] = kin(11)[pch + e]; lg[e] = kin(12)[pch + e]; lb[e] = kin(13)[pch + e]; }
    f32x4 g0, g1; v4u q1;
    const float* GCv = wsp<float>(F, WS_SSQ) + (size_t)(bh * 128) * 64; const float* GZ0 = F.H + (size_t)(bh * 128) * 8192; const bf16* QW0 = wsp<bf16>(F, WS_YRAW) + (size_t)(bh * 128) * 8192;
#define CS_LOAD(c_) do { const float* gp = GZ0 + (size_t)(c_) * 8192 + (tid >> 3) * 64 + (tid & 7) * 8; g0 = *(const f32x4*)gp; g1 = *(const f32x4*)(gp + 4); q1 = *(const v4u*)(QW0 + (size_t)(c_) * 8192 + (tid >> 3) * 64 + (tid & 7) * 8); } while (0)
    CS_LOAD(0);
    v4u prw, pkw, pvw, paw, pgw;
    { const size_t t0_ = (size_t)b * S + pt; prw = *(const v4u*)(RKV + t0_ * 1536 + C_R + pch); pkw = *(const v4u*)(RKV + t0_ * 1536 + C_K + pch); pvw = *(const v4u*)(RKV + t0_ * 1536 + C_V + pch);
      paw = *(const v4u*)(AA + t0_ * 512 + pch); pgw = *(const v4u*)(GG + t0_ * 512 + pch); }
    float cin[16];
#define CS_CIN(c_) do { if (wave < 4) { const float* zp = GZ0 + (size_t)(c_) * 8192 + 4096 + (bi * 32) * 64 + bj * 32 + col; \
            _Pragma("unroll") for (int r = 0; r < 16; ++r) cin[r] = zp[crow(r, hi) * 64]; } \
        else { const bf16* wp = QW0 + (size_t)(c_) * 8192 + 4096 + (bi * 32) * 64 + bj * 32 + col; \
            _Pragma("unroll") for (int r = 0; r < 16; ++r) cin[r] = bf1(wp[crow(r, hi) * 64]); } } while (0)
    CS_CIN(0);
    for (int c = 0; c < 128; ++c) {
        LAS float* Sc = (c & 1) ? SB : SA; LAS float* Sn = (c & 1) ? SA : SB;
        { LAS float* gd = GL + (tid >> 3) * CK_P + (tid & 7) * 8; LAS float* qd = QL + (tid >> 3) * CK_P + (tid & 7) * 8;
#pragma unroll
          for (int e = 0; e < 4; ++e) { gd[e] = g0[e]; gd[4 + e] = g1[e]; qd[2 * e] = bflo(q1[e]); qd[2 * e + 1] = bfhi(q1[e]); } }
        __syncthreads();
        asm volatile("" :: "v"(prw), "v"(pkw), "v"(pvw), "v"(paw), "v"(pgw));
#pragma unroll
        for (int r = 0; r < 16; ++r) asm volatile("" :: "v"(cin[r]));
        if (c + 1 < 128) CS_LOAD(c + 1);
        const size_t tok = (size_t)b * S + c * 64 + pt;
        const v4u rw = prw, kw = pkw, vw = pvw, aw = paw, gw4 = pgw;
        if (c + 1 < 128) { const size_t tn = tok + 64; prw = *(const v4u*)(RKV + tn * 1536 + C_R + pch); pkw = *(const v4u*)(RKV + tn * 1536 + C_K + pch); pvw = *(const v4u*)(RKV + tn * 1536 + C_V + pch);
            paw = *(const v4u*)(AA + tn * 512 + pch); pgw = *(const v4u*)(GG + tn * 512 + pch); }
        { f32x16_t acc;
#pragma unroll
          for (int r = 0; r < 16; ++r) acc[r] = cin[r];
          if (wave < 4) { const float gc = GCv[(size_t)c * 64 + bj * 32 + col];
#pragma unroll
              for (int r = 0; r < 16; ++r) acc[r] += Sc[(bi * 32 + crow(r, hi)) * CK_P + bj * 32 + col] * gc; }
          if (c + 1 < 128) CS_CIN(c + 1);
          mm32<CK_P, 1, CK_P, 1>(acc, Sc + bi * 32 * CK_P, (wave < 4 ? GL : QL) + bj * 32, lane);
#pragma unroll
          for (int r = 0; r < 16; ++r) { const int j = bi * 32 + crow(r, hi), q = bj * 32 + col; (wave < 4 ? Sn + j * CK_P + q : YL + q * CK_P + j)[0] = acc[r]; } }
        __syncthreads();
        {
          float y[8], r[8], k[8], v[8], al[8], g[8];
#pragma unroll
          for (int e = 0; e < 8; ++e) y[e] = YL[pt * CK_P + pk + e];
#pragma unroll
          for (int e = 0; e < 4; ++e) { r[2 * e] = bflo(rw[e]); r[2 * e + 1] = bfhi(rw[e]); k[2 * e] = bflo(kw[e]); k[2 * e + 1] = bfhi(kw[e]); v[2 * e] = bflo(vw[e]); v[2 * e + 1] = bfhi(vw[e]);
              al[2 * e] = bflo(aw[e]); al[2 * e + 1] = bfhi(aw[e]); g[2 * e] = bflo(gw4[e]); g[2 * e + 1] = bfhi(gw4[e]); }
          float s = 0.f, bs = 0.f;
#pragma unroll
          for (int e = 0; e < 8; ++e) { s += y[e]; const float kq = k[e] * (1.0f + (al[e] - 1.0f) * ka[e]); bs += r[e] * kq * rk[e]; }
          s = sum8(s); bs = sum8(bs);
          const float mean = s * (1.f / 64.f); float q = 0.f;
#pragma unroll
          for (int e = 0; e < 8; ++e) { const float d = y[e] - mean; q += d * d; }
          q = sum8(q);
          const float rstd = 1.0f / sqrtf(q * (1.f / 64.f) + GN_EPS); v4u o;
#pragma unroll
          for (int e = 0; e < 4; ++e) { const float o0 = ((y[2 * e] - mean) * rstd * lg[2 * e] + lb[2 * e] + bs * v[2 * e]) * g[2 * e], o1 = ((y[2 * e + 1] - mean) * rstd * lg[2 * e + 1] + lb[2 * e + 1] + bs * v[2 * e + 1]) * g[2 * e + 1]; o[e] = pk2(o0, o1); }
          *(v4u*)(YM + tok * 1024 + pch) = o; }
    }
#undef CS_LOAD
#undef CS_CIN
}

constexpr int MB_KSTR = 144, MB_VSTR = 192, MB_V = 256 * MB_KSTR, MB_END = MB_V + 256 * MB_VSTR;
constexpr int MB_LISTS = NB * NH * 31, MB_BHCAP = 126976, MB_PARTQ = 1024;
constexpr int MB_PU_OFF = 124 * 1024;
__device__ __forceinline__ int moba_off(int j) { return 256 * (31 * j - (j * (j - 1)) / 2); }
__device__ __forceinline__ void p13_moba_select(const Frame& F) {
    const int tid = F.tid, lane = tid & 63, wave = __builtin_amdgcn_readfirstlane(tid >> 6), r32 = lane & 31, hi = lane >> 5;
    LAS float* KL = (LAS float*)F.lds; LAS unsigned* lcnt = (LAS unsigned*)(F.lds + 8192); LAS unsigned* lbase = (LAS unsigned*)(F.lds + 8192 + 128);
    const bf16* P = wsp<bf16>(F, WS_PROJ1); const float* KM = wsp<float>(F, WS_KMEAN); unsigned* QL = wsp<unsigned>(F, WS_QLIST); gu32* CNT = (gu32*)(F.ws + WS_CTL) + CW_MOBA;
    for (int it = F.bid; it < NB * NH * 32; it += F.G) { const int bh = it >> 5, qb = ((it & 31) + 8 * (bh >> 3)) & 31, b = bh >> 3, h = bh & 7; if (qb == 0) continue;
        const int qpos = qb * 256 + wave * 32 + r32; const size_t tq = (size_t)b * S + qpos;
        float qv[4][8];
#pragma unroll
        for (int c = 0; c < 4; ++c) { const v4u w = *(const v4u*)(P + tq * IN1P + 1536 + h * 64 + 16 * c + 8 * hi);
#pragma unroll
            for (int e = 0; e < 4; ++e) { qv[c][2 * e] = bflo(w[e]); qv[c][2 * e + 1] = bfhi(w[e]); } }
        __syncthreads();
        { const float* km = KM + (size_t)bh * MOBA_NB * 64; for (int i = tid; i < qb * 64; i += NTHR) KL[i] = km[i]; if (tid < 32) lcnt[tid] = 0u; }
        __syncthreads();
        float v0 = -INFINITY, v1 = -INFINITY, v2 = -INFINITY; int i0 = -1, i1 = -1, i2 = -1;
        for (int n = 0; n < qb; ++n) { float g = 0.f;
#pragma unroll
            for (int c = 0; c < 4; ++c) { const f32x4 ka = *(const LAS f32x4*)(KL + n * 64 + 16 * c + 8 * hi), kb2 = *(const LAS f32x4*)(KL + n * 64 + 16 * c + 8 * hi + 4);
                g += (qv[c][0] * ka.x + qv[c][1] * ka.y) + (qv[c][2] * ka.z + qv[c][3] * ka.w) + (qv[c][4] * kb2.x + qv[c][5] * kb2.y) + (qv[c][6] * kb2.z + qv[c][7] * kb2.w); }
            g += __shfl_xor(g, 32);
            if (g > v0) { v2 = v1; i2 = i1; v1 = v0; i1 = i0; v0 = g; i0 = n; } else if (g > v1) { v2 = v1; i2 = i1; v1 = g; i1 = n; } else if (g > v2) { v2 = g; i2 = n; } }
        unsigned r0 = 0u, r1 = 0u, r2 = 0u;
        if (hi == 0) { if (i0 >= 0) r0 = __hip_atomic_fetch_add(lcnt + i0, 1u, __ATOMIC_RELAXED, __HIP_MEMORY_SCOPE_WORKGROUP); if (i1 >= 0) r1 = __hip_atomic_fetch_add(lcnt + i1, 1u, __ATOMIC_RELAXED, __HIP_MEMORY_SCOPE_WORKGROUP);
            if (i2 >= 0) r2 = __hip_atomic_fetch_add(lcnt + i2, 1u, __ATOMIC_RELAXED, __HIP_MEMORY_SCOPE_WORKGROUP); }
        __syncthreads();
        if (tid < 31) { const unsigned c = lcnt[tid]; lbase[tid] = c ? __hip_atomic_fetch_add(CNT + bh * 32 + tid, c, RLX_AGENT) : 0u; }
        __syncthreads();
        if (hi == 0) { unsigned* ql = QL + (size_t)bh * MB_BHCAP;
            if (i0 >= 0) ql[moba_off(i0) + lbase[i0] + r0] = (unsigned)qpos; if (i1 >= 0) ql[moba_off(i1) + lbase[i1] + r1] = (unsigned)qpos | (1u << 16); if (i2 >= 0) ql[moba_off(i2) + lbase[i2] + r2] = (unsigned)qpos | (2u << 16); }
    }
}
__device__ __forceinline__ void moba_unit(const Frame& F, int bh, int j, const unsigned* ql0, int nq, bool own, bool load = true) {
    constexpr float LOG2E = 1.4426950408889634f; const float scale = 0.125f * LOG2E;
    int tid_ = F.tid; asm volatile("" : "+v"(tid_)); const int tid = tid_, lane = tid & 63, wave = __builtin_amdgcn_readfirstlane(tid >> 6), r32 = lane & 31, hi = lane >> 5;
    const int b = bh >> 3, h = bh & 7; LAS unsigned char* L = F.lds;
    const bf16* P = wsp<bf16>(F, WS_PROJ1); bf16* PO = wsp<bf16>(F, WS_PARTO); float* PML = wsp<float>(F, WS_PARTML);
    if (load) {
    __syncthreads();
    { const bf16* kg = P + ((size_t)b * S + j * 256) * IN1P + 2048 + h * 64; const bf16* vg = P + ((size_t)b * S + j * 256) * IN1P + 2560 + h * 64;
#pragma unroll
      for (int u = 0; u < 4; ++u) { const int pc = tid + u * NTHR, row = pc >> 3, sc = pc & 7; const v4u kw = *(const v4u*)(kg + (size_t)row * IN1P + sc * 8), vw = *(const v4u*)(vg + (size_t)row * IN1P + sc * 8);
          *(LAS v4u*)(L + row * MB_KSTR + sc * 16) = kw; *(LAS v4u*)(L + MB_V + row * MB_VSTR + sc * 16) = vw; } }
    __syncthreads();
    }
    const int kfoff = r32 * MB_KSTR + hi * 16, vtoff = MB_V + (4 * hi + ((lane & 15) >> 2)) * MB_VSTR + (((lane >> 4) & 1) * 16 + (lane & 3) * 4) * 2;
    const int ng = (nq + 31) >> 5;
    for (int g = wave; g < ng; g += NWAVES) {
        const int idx = g * 32 + r32; const bool valid = idx < nq; const int ic = valid ? idx : nq - 1;
        const unsigned ent = own ? ((unsigned)(j * 256 + ic) | (3u << 16)) : ql0[ic]; const int qpos = (int)(ent & 0xffffu), slot = (int)(ent >> 16); const size_t tq = (size_t)b * S + qpos;
        bf16x8_t qf[4];
#pragma unroll
        for (int c = 0; c < 4; ++c) { const v4u w = *(const v4u*)(P + tq * IN1P + 1536 + h * 64 + 16 * c + 8 * hi); v4u o;
#pragma unroll
            for (int e = 0; e < 4; ++e) o[e] = cvtpk(bflo(w[e]) * scale, bfhi(w[e]) * scale);
            qf[c] = __builtin_bit_cast(bf16x8_t, o); }
        f32x16_t o0 = {}, o1 = {}; float m = 0.f, l = 0.f;
        const int tlast = own ? ((g * 32 + 31) >> 6) : 3;
#pragma unroll 1
        for (int t = 0; t <= tlast; ++t) {
            f32x16_t s0, s1;
#pragma unroll
            for (int r = 0; r < 16; ++r) { s0[r] = -m; s1[r] = -m; }
            const LAS unsigned char* kb = L + (64 * t) * MB_KSTR + kfoff;
#pragma unroll
            for (int c = 0; c < 4; ++c) { const bf16x8_t k0 = *(const LAS bf16x8_t*)(kb + c * 32), k1 = *(const LAS bf16x8_t*)(kb + 32 * MB_KSTR + c * 32);
                s0 = __builtin_amdgcn_mfma_f32_32x32x16_bf16(k0, qf[c], s0, 0, 0, 0); s1 = __builtin_amdgcn_mfma_f32_32x32x16_bf16(k1, qf[c], s1, 0, 0, 0); }
            if (own) {
#pragma unroll
                for (int r = 0; r < 16; ++r) { const int kv = 64 * t + crow(r, hi); if (kv > ic) s0[r] = -1e30f; if (kv + 32 > ic) s1[r] = -1e30f; } }
            float mxa = fmaxf(fmaxf(s0[0], s0[1]), fmaxf(s1[0], s1[1])), mxb = fmaxf(fmaxf(s0[2], s0[3]), fmaxf(s1[2], s1[3]));
#pragma unroll
            for (int r = 4; r < 16; r += 2) { mxa = fmaxf(mxa, fmaxf(s0[r], s1[r])); mxb = fmaxf(mxb, fmaxf(s0[r + 1], s1[r + 1])); }
            float mx = fmaxf(mxa, mxb);
            { auto rr = __builtin_amdgcn_permlane32_swap(__builtin_bit_cast(unsigned, mx), __builtin_bit_cast(unsigned, mx), false, false); mx = fmaxf(__builtin_bit_cast(float, rr[0]), __builtin_bit_cast(float, rr[1])); }
            if (__ballot(mx > 8.0f) != 0ull) { const float dl = fmaxf(mx, 0.f), corr = __builtin_amdgcn_exp2f(-dl); m += dl; l *= corr;
#pragma unroll
                for (int r = 0; r < 16; ++r) { s0[r] -= dl; s1[r] -= dl; o0[r] *= corr; o1[r] *= corr; } }
            float la = 0.f, lb = 0.f;
#pragma unroll
            for (int r = 0; r < 16; ++r) { s0[r] = __builtin_amdgcn_exp2f(s0[r]); s1[r] = __builtin_amdgcn_exp2f(s1[r]); la += s0[r]; lb += s1[r]; }
            l += la + lb;
            const LAS unsigned char* vb = L + vtoff + (64 * t) * MB_VSTR;
#pragma unroll
            for (int ts = 0; ts < 4; ++ts) { v4u pw; const int rb = 8 * (ts & 1);
                if (ts < 2) { pw.x = cvtpk(s0[rb], s0[rb + 1]); pw.y = cvtpk(s0[rb + 2], s0[rb + 3]); pw.z = cvtpk(s0[rb + 4], s0[rb + 5]); pw.w = cvtpk(s0[rb + 6], s0[rb + 7]); }
                else { pw.x = cvtpk(s1[rb], s1[rb + 1]); pw.y = cvtpk(s1[rb + 2], s1[rb + 3]); pw.z = cvtpk(s1[rb + 4], s1[rb + 5]); pw.w = cvtpk(s1[rb + 6], s1[rb + 7]); }
                const bf16x8_t pf = __builtin_bit_cast(bf16x8_t, pw);
#pragma unroll
                for (int db = 0; db < 2; ++db) {
                    const s16x4_t a = __builtin_bit_cast(s16x4_t, __builtin_amdgcn_ds_read_tr16_b64_v4i16((LAS s16x4_t*)(vb + ts * 16 * MB_VSTR + db * 64)));
                    const s16x4_t c = __builtin_bit_cast(s16x4_t, __builtin_amdgcn_ds_read_tr16_b64_v4i16((LAS s16x4_t*)(vb + (ts * 16 + 8) * MB_VSTR + db * 64)));
                    const bf16x8_t vf = (bf16x8_t){a[0], a[1], a[2], a[3], c[0], c[1], c[2], c[3]};
                    if (db == 0) o0 = __builtin_amdgcn_mfma_f32_32x32x16_bf16(vf, pf, o0, 0, 0, 0); else o1 = __builtin_amdgcn_mfma_f32_32x32x16_bf16(vf, pf, o1, 0, 0, 0); } }
        }
        l += __shfl_xor(l, 32); const float il = 1.0f / l;
        const size_t pidx = (tq * 8 + h) * 4 + slot;
        if (valid) { bf16* Op = PO + pidx * 64 + 4 * hi;
#pragma unroll
            for (int gq = 0; gq < 4; ++gq) { v2u w0, w1; w0.x = cvtpk(o0[4 * gq] * il, o0[4 * gq + 1] * il); w0.y = cvtpk(o0[4 * gq + 2] * il, o0[4 * gq + 3] * il); w1.x = cvtpk(o1[4 * gq] * il, o1[4 * gq + 1] * il); w1.y = cvtpk(o1[4 * gq + 2] * il, o1[4 * gq + 3] * il);
                *(v2u*)(Op + 8 * gq) = w0; *(v2u*)(Op + 32 + 8 * gq) = w1; }
            if (hi == 0) { PML[pidx * 2] = m; PML[pidx * 2 + 1] = l; } }
    }
}
__device__ __forceinline__ void layer1_attn_phase(const Frame& F, gu32* ctr) {
    volatile LAS unsigned* slot = (volatile LAS unsigned*)(F.lds + MISC_OFF + 64); LAS int* PU = (LAS int*)(F.lds + MB_PU_OFF); LAS int* BT = (LAS int*)(F.lds + MB_PU_OFF + 4096);
    gu32* CNT = (gu32*)(F.ws + WS_CTL) + CW_MOBA;
    LAS int* CL = (LAS int*)F.lds;
    __syncthreads();
    for (int i = F.tid; i < NB * NH * 32; i += NTHR) { const int np_ = (i & 31) < 31 ? ((int)__hip_atomic_load(CNT + i, RLX_AGENT) + MB_PARTQ - 1) / MB_PARTQ : 0; CL[i] = np_ > 1 ? np_ - 1 : 0; }
    __syncthreads();
    if (F.tid < 32) { int s = 0; for (int j = 0; j < 31; ++j) s += CL[F.tid * 32 + j]; BT[F.tid] = s; }
    __syncthreads();
    for (int id = F.tid; id < MB_LISTS; id += NTHR) { const int bh = id / 31, j = id % 31; int s = 0; for (int k = 0; k < bh; ++k) s += BT[k];
        for (int k = 0; k < j; ++k) s += CL[bh * 32 + k]; PU[id] = s; }
    if (F.tid == 0) { int s = 0; for (int k = 0; k < 32; ++k) s += BT[k]; PU[MB_LISTS] = s; }
    __syncthreads();
    const int NF = NB * NH * 32, NO = NB * NH * 32, NGU = PU[MB_LISTS];
    unsigned tkt = 0u; bool have = false;
    for (;;) {
        __syncthreads();
        if (F.tid == 0) *slot = have ? tkt : __hip_atomic_fetch_add(ctr, 1u, RLX_AGENT);
        __syncthreads();
        const int u = (int)__builtin_amdgcn_readfirstlane(*slot);
        if (u >= NF + NO + NGU) break;
        have = u + 2 * F.G < NF + NO + NGU; if (have && F.tid == 0) tkt = __hip_atomic_fetch_add(ctr, 1u, RLX_AGENT);
        if (u < NF) { const int qb = 31 - u / (NB * NH), bh = u % (NB * NH); attn_unit<1>(F, bh >> 3, bh & 7, qb); }
        else if (u >= NF + NGU) { const int m_ = u - NF - NGU, qb = m_ / (NB * NH), bh = m_ % (NB * NH); moba_unit(F, bh, qb, nullptr, 256, true);
            if (qb < 31) { const int cnt = (int)__builtin_amdgcn_readfirstlane((int)__hip_atomic_load(CNT + bh * 32 + qb, RLX_AGENT));
                if (cnt > 0) moba_unit(F, bh, qb, wsp<unsigned>(F, WS_QLIST) + (size_t)bh * MB_BHCAP + moba_off(qb), cnt < MB_PARTQ ? cnt : MB_PARTQ, false, false); } }
        else { const int gidx = u - NF; int lo = 0, hi_ = MB_LISTS;
            while (hi_ - lo > 1) { const int mid = (lo + hi_) >> 1; if (PU[mid] <= gidx) lo = mid; else hi_ = mid; }
            const int bh = lo / 31, j = lo % 31, part = gidx - PU[lo] + 1; const int cnt = (int)__builtin_amdgcn_readfirstlane((int)__hip_atomic_load(CNT + bh * 32 + j, RLX_AGENT));
            const int q0 = part * MB_PARTQ, nq = cnt - q0 < MB_PARTQ ? cnt - q0 : MB_PARTQ;
            moba_unit(F, bh, j, wsp<unsigned>(F, WS_QLIST) + (size_t)bh * MB_BHCAP + moba_off(j) + q0, nq, false); }
    }
}
__device__ __forceinline__ void p14_moba_combine(const Frame& F) {
    const int gw = F.bid * NWAVES + F.wave, NGW = F.G * NWAVES, lane = F.lane, h = lane >> 3, d8 = (lane & 7) * 8;
    const bf16* PO = wsp<bf16>(F, WS_PARTO); const float* PML = wsp<float>(F, WS_PARTML); bf16* YM = wsp<bf16>(F, WS_YMIX);
    for (int t = gw; t < T; t += NGW) { const int own = (t % S) >> 8, nv = own < 3 ? own : 3; const size_t p0 = ((size_t)t * 8 + h) * 4;
        float mm[4], ll[4]; v4u ov[4]; float M = -1e30f;
#pragma unroll
        for (int s = 0; s < 4; ++s) { const bool use = s == 3 || s < nv; mm[s] = -1e30f; ll[s] = 0.f; ov[s] = (v4u){0u, 0u, 0u, 0u};
            if (use) { mm[s] = PML[(p0 + s) * 2]; ll[s] = PML[(p0 + s) * 2 + 1]; ov[s] = *(const v4u*)(PO + (p0 + s) * 64 + d8); M = fmaxf(M, mm[s]); } }
        float acc[8], wsum = 0.f;
#pragma unroll
        for (int e = 0; e < 8; ++e) acc[e] = 0.f;
#pragma unroll
        for (int s = 0; s < 4; ++s) { const float w = ll[s] * __builtin_amdgcn_exp2f(mm[s] - M); wsum += w;
#pragma unroll
            for (int e = 0; e < 4; ++e) { acc[2 * e] += w * bflo(ov[s][e]); acc[2 * e + 1] += w * bfhi(ov[s][e]); } }
        const float iw = 1.0f / wsum; v4u o;
#pragma unroll
        for (int e = 0; e < 4; ++e) o[e] = pk2(acc[2 * e] * iw, acc[2 * e + 1] * iw);
        *(v4u*)(YM + (size_t)t * 1024 + 512 + h * 64 + d8) = o; }
}

__device__ __forceinline__ void p11_dcum(const Frame& F) {
    if (F.bid >= NB * NH) return;
    const int b = F.bid >> 3, h = F.bid & 7, tid = F.tid, lane = F.lane; LAS float* ws = (LAS float*)F.lds;
    const float* LF = wsp<float>(F, WS_LOGF) + ((size_t)b * S) * 8 + h; float* DC = wsp<float>(F, WS_DCUM) + ((size_t)b * S) * 8 + h;
    static_assert(S == NTHR * 16, "dcum: 16 steps per thread");
    float v[16];
#pragma unroll
    for (int j = 0; j < 16; ++j) v[j] = LF[(size_t)(tid * 16 + j) * 8];
#pragma unroll
    for (int j = 1; j < 16; ++j) v[j] += v[j - 1];
    float inc = v[15];
#pragma unroll
    for (int o = 1; o < 64; o <<= 1) { const float n = __shfl_up(inc, o); if (lane >= o) inc += n; }
    if (lane == 63) ws[F.wave] = inc;
    __syncthreads();
    float off = inc - v[15];
    for (int w = 0; w < F.wave; ++w) off += ws[w];
#pragma unroll
    for (int j = 0; j < 16; ++j) DC[(size_t)(tid * 16 + j) * 8] = v[j] + off;
}
__device__ __forceinline__ void p11_knorm(const Frame& F) {
    const int gw = F.bid * NWAVES + F.wave, NGW = F.G * NWAVES, lane = F.lane; const bf16* P = wsp<bf16>(F, WS_PROJ1); float* KN = wsp<float>(F, WS_KMEAN) + 65536;
    for (int it = gw; it < NB * NH * 128; it += NGW) { const int tile = it & 127, h = (it >> 7) & 7, b = it >> 10; const bf16* kp = P + ((size_t)b * S + tile * 64 + lane) * IN1P + 512 + h * 64; float s2 = 0.f;
#pragma unroll
        for (int c = 0; c < 8; ++c) { const v4u w = *(const v4u*)(kp + 8 * c);
#pragma unroll
            for (int e = 0; e < 4; ++e) { const float a0 = bflo(w[e]), a1 = bfhi(w[e]); s2 += a0 * a0 + a1 * a1; } }
#pragma unroll
        for (int o = 1; o < 64; o <<= 1) s2 = fmaxf(s2, __shfl_xor(s2, o));
        if (lane == 0) KN[it] = sqrtf(s2); }
}
__device__ __forceinline__ void p11_moba_rope(const Frame& F) {
    const int tid = F.tid, lane = tid & 63, wave = __builtin_amdgcn_readfirstlane(tid >> 6); LAS float* L = (LAS float*)F.lds;
    const int l5 = lane & 31, par = lane >> 5, ten = l5 >> 4, hl = (l5 >> 2) & 3, qd = l5 & 3;
    const float* r64 = wsp<float>(F, WS_ROPE64); bf16* P = wsp<bf16>(F, WS_PROJ1); float* KM = wsp<float>(F, WS_KMEAN);
    for (int item = F.bid; item < NB * MOBA_NB * 2; item += F.G) {
        const int hh = item & 1, n = (item >> 1) % MOBA_NB, b = item / (2 * MOBA_NB); const int col = 1536 + ten * 512 + (4 * hh + hl) * 64 + 8 * qd;
        float acc[16];
#pragma unroll
        for (int e = 0; e < 16; ++e) acc[e] = 0.f;
        for (int ig = 0; ig < 4; ++ig) {
            v4u w1[4], w2[4]; f32x4 tt[4][4];
#pragma unroll
            for (int u = 0; u < 4; ++u) { const int pos = n * MOBA_BLK + 32 * wave + 2 * (4 * ig + u) + par; const bf16* p = P + ((size_t)b * S + pos) * IN1P + col;
                w1[u] = *(const v4u*)p; w2[u] = *(const v4u*)(p + 32); const f32x4* tb = (const f32x4*)(r64 + ((size_t)pos * 32 + 8 * qd) * 2); tt[u][0] = tb[0]; tt[u][1] = tb[1]; tt[u][2] = tb[2]; tt[u][3] = tb[3]; }
#pragma unroll
            for (int u = 0; u < 4; ++u) { const int pos = n * MOBA_BLK + 32 * wave + 2 * (4 * ig + u) + par; bf16* p = P + ((size_t)b * S + pos) * IN1P + col;
                float o1[8], o2[8];
#pragma unroll
                for (int e = 0; e < 4; ++e) { const float a0 = bflo(w1[u][e]), a1 = bfhi(w1[u][e]), b0 = bflo(w2[u][e]), b1 = bfhi(w2[u][e]); const f32x4 cs = tt[u][e];
                    o1[2 * e] = a0 * cs.x - b0 * cs.y; o2[2 * e] = b0 * cs.x + a0 * cs.y; o1[2 * e + 1] = a1 * cs.z - b1 * cs.w; o2[2 * e + 1] = b1 * cs.z + a1 * cs.w; }
                v4u s1, s2;
#pragma unroll
                for (int e = 0; e < 4; ++e) { s1[e] = pk2(o1[2 * e], o1[2 * e + 1]); s2[e] = pk2(o2[2 * e], o2[2 * e + 1]); }
                *(v4u*)p = s1; *(v4u*)(p + 32) = s2;
#pragma unroll
                for (int e = 0; e < 8; ++e) { acc[e] += o1[e]; acc[8 + e] += o2[e]; } }
        }
        __syncthreads();
        if (ten == 1) { LAS f32x4* d = (LAS f32x4*)(L + ((wave * 2 + par) * 16 + (l5 & 15)) * 16);
#pragma unroll
            for (int e = 0; e < 4; ++e) d[e] = (f32x4){acc[4 * e], acc[4 * e + 1], acc[4 * e + 2], acc[4 * e + 3]}; }
        __syncthreads();
        if (tid < 256) { const int l4 = tid >> 4, e = tid & 15; float s = 0.f;
#pragma unroll
            for (int w = 0; w < 16; ++w) s += L[(w * 16 + l4) * 16 + e];
            const int hl2 = l4 >> 2, qd2 = l4 & 3, d = (e < 8 ? 8 * qd2 + e : 32 + 8 * qd2 + (e - 8));
            KM[(((size_t)b * NH + 4 * hh + hl2) * MOBA_NB + n) * 64 + d] = s * (1.f / 256.f); }
    }
}
__device__ __forceinline__ void logf_body(const Frame& F, int mm, const f32x4 (&v)[4], float fbias) {
    float o[8]; row_dot8(F, v, o);
    if (F.lane < 8) { float x = 0.f;
#pragma unroll
        for (int e = 0; e < 8; ++e) x = F.lane == e ? o[e] : x;
        x += fbias; const float ls = fminf(x, 0.f) - log1pf(__expf(-fabsf(x))); wsp<float>(F, WS_LOGF)[(size_t)mm * 8 + F.lane] = ls; }
}
__device__ __forceinline__ void p9_norm_logf(const Frame& F, const Args& a) {
    const int gw = F.bid * NWAVES + F.wave, NGW = F.G * NWAVES; f32x4 v[4]; float o[8];
    stage_w8(F, kin(24), IN1, 1536);
    const float fb_ = F.lane < 8 ? kin(25)[F.lane] : 0.f;
    RMS_ROWS(wsp<bf16>(F, WS_HB), kin(23), wsp<bf16>(F, WS_XNL1), logf_body(F, mm, v, fb_));
}
__device__ __forceinline__ void route_body(const Frame& F, int mm, const f32x4 (&v)[4], LAS unsigned* lcnt, int* TE, int* TP, float* TG) {
    float o[8]; row_dot8(F, v, o);
    int e0 = 0; float l0 = o[0];
#pragma unroll
    for (int e = 1; e < 8; ++e) if (o[e] > l0) { l0 = o[e]; e0 = e; }
    int e1 = -1; float l1 = -INFINITY;
#pragma unroll
    for (int e = 0; e < 8; ++e) if (e != e0 && o[e] > l1) { l1 = o[e]; e1 = e; }
    if (F.lane == 0) { const float g1 = 1.0f / (1.0f + __expf(l0 - l1)), g0 = 1.0f - g1;
        const int p0 = (int)__hip_atomic_fetch_add(lcnt + e0, 1u, __ATOMIC_RELAXED, __HIP_MEMORY_SCOPE_WORKGROUP), p1 = (int)__hip_atomic_fetch_add(lcnt + e1, 1u, __ATOMIC_RELAXED, __HIP_MEMORY_SCOPE_WORKGROUP);
        TE[2 * mm] = e0; TE[2 * mm + 1] = e1; TP[2 * mm] = p0; TP[2 * mm + 1] = p1; TG[2 * mm] = g0; TG[2 * mm + 1] = g1; }
}
__device__ __forceinline__ void p14_norm_route(const Frame& F, const Args& a) {
    const int gw = F.bid * NWAVES + F.wave, NGW = F.G * NWAVES; f32x4 v[4]; float o[8]; gu32* cnt = (gu32*)(F.ws + WS_CTL) + CW_CNT;
    LAS unsigned* lcnt = (LAS unsigned*)(F.lds + 110 * 1024);
    if (F.tid < 8) lcnt[F.tid] = 0u;
    stage_w8(F, kin(28), NE, 0);
    int* TE = wsp<int>(F, WS_TOPE); int* TP = wsp<int>(F, WS_TOPP); float* TG = wsp<float>(F, WS_TOPG);
    RMS_ROWS(wsp<bf16>(F, WS_HB), kin(27), wsp<unsigned char>(F, WS_XN2), route_body(F, mm, v, lcnt, TE, TP, TG));
    __syncthreads();
    if (F.tid < 8) wsp<int>(F, WS_TILEE)[1024 + F.bid * 8 + F.tid] = (int)__hip_atomic_fetch_add(cnt + F.tid, lcnt[F.tid], RLX_AGENT);
}
__device__ __forceinline__ void p15_gather_convert(const Frame& F, const Args& a) {
    const int gw = F.bid * NWAVES + F.wave, NGW = F.G * NWAVES, lane = F.lane; gu32* cnt = (gu32*)(F.ws + WS_CTL) + CW_CNT;
    int base[9]; base[0] = 0;
#pragma unroll
    for (int e = 0; e < 8; ++e) { const int c = (int)__hip_atomic_load(cnt + e, RLX_AGENT); base[e + 1] = base[e] + ((c + 255) >> 8) * 256; }
    int* TLE = wsp<int>(F, WS_TILEE);
    if (F.bid == 0 && F.tid < MOE_MAX_TILES) { const int rt = F.tid; int e = 0;
#pragma unroll
        for (int j = 1; j < 8; ++j) if (rt * 256 >= base[j]) e = j;
        TLE[rt] = e; if (rt == 0) TLE[512] = base[8] >> 8; }
    const int* TE = wsp<int>(F, WS_TOPE); const int* TP = wsp<int>(F, WS_TOPP); int* PR = wsp<int>(F, WS_PROW); const unsigned char* XN = wsp<unsigned char>(F, WS_XN2); unsigned char* XG = wsp<unsigned char>(F, WS_XG8);
    constexpr int GT = 8;
    for (int m0 = gw * GT; m0 < T; m0 += NGW * GT) { int rowA[GT], rowB[GT]; v4u s0[GT];
#pragma unroll
        for (int u = 0; u < GT; ++u) { const int m = m0 + u; const int e0 = TE[2 * m], e1 = TE[2 * m + 1], p0 = TP[2 * m], p1 = TP[2 * m + 1]; const int blk = (m % NGW) >> 3; int b0 = 0, b1 = 0;
#pragma unroll
            for (int j = 0; j < 8; ++j) { b0 = e0 == j ? base[j] : b0; b1 = e1 == j ? base[j] : b1; }
            rowA[u] = b0 + TLE[1024 + blk * 8 + e0] + p0; rowB[u] = b1 + TLE[1024 + blk * 8 + e1] + p1;
            s0[u] = ((const v4u*)(XN + (size_t)m * D))[lane]; }
#pragma unroll
        for (int u = 0; u < GT; ++u) { const int m = m0 + u; if (lane == 0) { PR[2 * m] = rowA[u]; PR[2 * m + 1] = rowB[u]; }
            ((v4u*)(XG + (size_t)rowA[u] * D))[lane] = s0[u]; ((v4u*)(XG + (size_t)rowB[u] * D))[lane] = s0[u]; } }
    LAS float* scr = (LAS float*)(F.lds + F.wave * 16384); int itb = 0;
    for (int e = 0; e < NE; ++e) {
        tr_matrix8<1>(F, itb, kin(29) + (size_t)e * D * DE, DE, D, 0, DE / 32, wsp<unsigned char>(F, WS_WMOE_GU) + (size_t)e * 2 * DE * D, D, 0, scr, F8_SW1);
        tr_matrix8<1>(F, itb, kin(30) + (size_t)e * D * DE, DE, D, 0, DE / 32, wsp<unsigned char>(F, WS_WMOE_GU) + (size_t)e * 2 * DE * D, D, 128, scr, F8_SW1);
        tr_matrix8<0>(F, itb, kin(31) + (size_t)e * DE * D, D, DE, 0, D / 32, wsp<unsigned char>(F, WS_WMOE_D) + (size_t)e * D * DE, DE, 0, scr, F8_SW2);
    }
}
struct FinIdx { int r0, r1; float g0, g1; };
struct FinRaw { v2u h[4], y0[4], y1[4]; };
constexpr int FIN_XROW0 = MOE_NPASS * MOE_PASS_TILES * 256;
__device__ __forceinline__ void fin_idx(FinIdx& q, const int* PR, const float* TG, int m) { q.r0 = PR[2 * m]; q.r1 = PR[2 * m + 1]; q.g0 = TG[2 * m]; q.g1 = TG[2 * m + 1]; }
__device__ __forceinline__ void fin_load(FinRaw& w, const FinIdx& q, const bf16* HB, const bf16* Y, int m, int lane) {
    const v2u* hr = (const v2u*)(HB + (size_t)m * D) + lane;
#pragma unroll
    for (int j = 0; j < 4; ++j) w.h[j] = hr[64 * j];
    const int r0 = q.r0 < FIN_XROW0 ? q.r0 : 0, r1 = q.r1 < FIN_XROW0 ? q.r1 : 0;
    const v2u* y0 = (const v2u*)(Y + (size_t)r0 * D) + lane; const v2u* y1 = (const v2u*)(Y + (size_t)r1 * D) + lane;
#pragma unroll
    for (int j = 0; j < 4; ++j) { w.y0[j] = y0[64 * j]; w.y1[j] = y1[64 * j]; }
}
__device__ __forceinline__ void fin_finish(const FinRaw& w, const FinIdx& q, const f32x4 (&gfin)[4], float* OUT, const bf16* YP, int m, int lane) {
    constexpr size_t SLAB = (size_t)MOE_XTILES * 256 * D;
    f32x4 v[4]; float s = 0.f;
#pragma unroll
    for (int j = 0; j < 4; ++j) v[j] = (f32x4){bflo(w.h[j].x), bfhi(w.h[j].x), bflo(w.h[j].y), bfhi(w.h[j].y)};
#pragma unroll
    for (int e = 0; e < 2; ++e) { const int r = e ? q.r1 : q.r0; const float g = e ? q.g1 : q.g0;
        if (r < FIN_XROW0) {
#pragma unroll
            for (int j = 0; j < 4; ++j) { const v2u a0 = e ? w.y1[j] : w.y0[j]; v[j].x += g * bflo(a0.x); v[j].y += g * bfhi(a0.x); v[j].z += g * bflo(a0.y); v[j].w += g * bfhi(a0.y); } }
        else { f32x4 acc[4];
#pragma unroll
            for (int j = 0; j < 4; ++j) acc[j] = (f32x4){0.f, 0.f, 0.f, 0.f};
            for (int sl = 0; sl < MOE_KSPLIT; ++sl) { const v2u* y = (const v2u*)(YP + (size_t)sl * SLAB + (size_t)(r - FIN_XROW0) * D) + lane;
#pragma unroll
                for (int j = 0; j < 4; ++j) { const v2u a0 = y[64 * j]; acc[j].x += bflo(a0.x); acc[j].y += bfhi(a0.x); acc[j].z += bflo(a0.y); acc[j].w += bfhi(a0.y); } }
#pragma unroll
            for (int j = 0; j < 4; ++j) v[j] += acc[j] * g; } }
#pragma unroll
    for (int j = 0; j < 4; ++j) s += (v[j].x * v[j].x + v[j].y * v[j].y) + (v[j].z * v[j].z + v[j].w * v[j].w);
    const float rstd = 1.0f / sqrtf(wave_sum(s) * (1.f / D) + NORM_EPS);
    f32x4* hr = (f32x4*)(OUT + (size_t)m * D) + lane;
#pragma unroll
    for (int j = 0; j < 4; ++j) __builtin_nontemporal_store(v[j] * rstd * gfin[j], hr + 64 * j);
}
__device__ __forceinline__ void p_final(const Frame& F, const Args& a) {
    const int gw = F.bid * NWAVES + F.wave, NGW = F.G * NWAVES, lane = F.lane;
    const int* PR = wsp<int>(F, WS_PROW); const float* TG = wsp<float>(F, WS_TOPG); const bf16* Y = wsp<bf16>(F, WS_XG); const bf16* YP = wsp<bf16>(F, WS_YP); const bf16* HB = wsp<bf16>(F, WS_HB);
    if (gw >= T) return;
    f32x4 gfin[4];
#pragma unroll
    for (int j = 0; j < 4; ++j) gfin[j] = ((const f32x4*)kin(32))[lane + 64 * j];
    FinIdx ia, ib; FinRaw wa, wb;
    fin_idx(ia, PR, TG, gw); if (gw + NGW < T) fin_idx(ib, PR, TG, gw + NGW);
    fin_load(wa, ia, HB, Y, gw, lane);
    for (int m = gw; m < T; m += 2 * NGW) {
        FinIdx ic = ia, id = ib;
        if (m + NGW < T) fin_load(wb, ib, HB, Y, m + NGW, lane);
        if (m + 2 * NGW < T) fin_idx(ic, PR, TG, m + 2 * NGW);
        fin_finish(wa, ia, gfin, F.H, YP, m, lane);
        if (m + NGW < T) {
            if (m + 2 * NGW < T) fin_load(wa, ic, HB, Y, m + 2 * NGW, lane);
            if (m + 3 * NGW < T) fin_idx(id, PR, TG, m + 3 * NGW);
            fin_finish(wb, ib, gfin, F.H, YP, m + NGW, lane); }
        ia = ic; ib = id;
    }
}
__device__ __forceinline__ void p_norm(const Frame& F, const float* gain) {
    const int gw = F.bid * NWAVES + F.wave, NGW = F.G * NWAVES; f32x4 v[4];
    RMS_ROWS(wsp<bf16>(F, WS_HB), gain, wsp<bf16>(F, WS_XNF), (void)mm);
}

constexpr int N_PHASES = 26;
__global__ void __launch_bounds__(NTHR, 2) hybrid_fwd(Args args) {
    extern __shared__ __attribute__((aligned(16))) unsigned char lds[];
    Frame F; F.lds = (LAS unsigned char*)lds; F.ws = args.ws; F.H = args.out;
    F.tid = threadIdx.x; F.lane = F.tid & 63; F.wave = __builtin_amdgcn_readfirstlane(F.tid >> 6); F.G = gridDim.x; F.bid = blockIdx.x;
    volatile LAS unsigned* MISC = (volatile LAS unsigned*)(F.lds + MISC_OFF);
    for (int u = F.tid; u < (LDS_BYTES - LDSCTL_OFF) / 4; u += NTHR) ((LAS unsigned*)(F.lds + LDSCTL_OFF))[u] = 0u;
    __syncthreads();
    gu32* ctl = (gu32*)(args.ws + WS_CTL);
    const int lo = args.ph_lo, hi = args.ph_hi;
    XcdBarrier bar; bar.bar = (unsigned*)(ctl + CW_BAR); bar.x = 0; bar.st = nullptr;
    if (hi - lo > 1) bar = xcd_barrier_post((unsigned*)(ctl + CW_BAR), MISC + 8);
#ifndef PHMASK
#define PHMASK 0xffffffffffffffffull
#endif
#define IN(k) (((PHMASK >> ((k) < 18 ? (k) : ((k) == 26 ? 20 : 18 + ((k) & 1)))) & 1ull) && lo <= (k) && (k) < hi)
#define SEAM(k) do { if (IN(k) && IN((k) + 1)) xcd_barrier(bar); { int t_ = threadIdx.x; asm volatile("" : "+v"(t_)); F.tid = t_; F.lane = t_ & 63; } } while (0)
#ifndef PROBE_DUP
#define PROBE_DUP (-1)
#endif
#define REPS(k) ((PROBE_DUP == (k)) ? 2 : 1)
#ifndef PROBE_MASK
#define PROBE_MASK 0u
#endif
#ifndef PROBE_REPN
#define PROBE_REPN 1
#endif
#define PDUP(k, body) do { body; if ((PROBE_MASK >> (k)) & 1u) { for (int rp_ = 0; rp_ < PROBE_REPN; ++rp_) { xcd_barrier(bar); body; } } } while (0)
#define REPBAR(k) do { if (rep + 1 < REPS(k)) xcd_barrier(bar); } while (0)
    LAS unsigned char* ring = F.lds + RING_OFF;
    bf16* XN = wsp<bf16>(F, WS_XN);

    if (IN(0)) { PDUP(0, p0_prologue(F, args)); } SEAM(0);
    if (PROBE_DUP == 777 && IN(1)) { for (int k_ = 0; k_ < 20; ++k_) xcd_barrier(bar); }
    if (IN(1)) { pg8::Gemm g{XN, wsp<bf16>(F, WS_WIN0), T, IN0P, D}; pg8::StaticOrder So; So.init(T, IN0P, F.G, F.bid); pg8::EpiStore E{wsp<bf16>(F, WS_PROJ0), IN0P, 0};
        pg8::gemm_phase<pg8::EpiStore, pg8::StaticOrder, true, true>(ring, g, So, E); } SEAM(1);
    if (IN(2)) { PDUP(2, p2_prep0(F, args)); } SEAM(2);
    if (IN(3)) {
        { pg8::Gemm g{wsp<bf16>(F, WS_LIN), wsp<bf16>(F, WS_WLORA), T, 1536, 256}; pg8::StaticOrder So; So.init(T, 1536, F.G, F.bid); pg8::EpiLora E{wsp<bf16>(F, WS_EW), kin(4), kin(6)};
          pg8::gemm_phase<pg8::EpiLora, pg8::StaticOrder, true, true>(ring, g, So, E); }
        __syncthreads();
        { pg8::Gemm g{wsp<bf16>(F, WS_QN), wsp<bf16>(F, WS_WUQ), T, 768, QR}; pg8::StaticOrder So; So.init(T, 768, F.G, F.bid); pg8::EpiStore E{wsp<bf16>(F, WS_QM), 768, 0};
          pg8::gemm_phase<pg8::EpiStore, pg8::StaticOrder, true, true>(ring, g, So, E); }
        __syncthreads();
        { pg8::Gemm g{wsp<bf16>(F, WS_KVN), wsp<bf16>(F, WS_WUKV), T, 1024, KVR}; pg8::StaticOrder So; So.init(T, 1024, F.G, F.bid); pg8::EpiStore E{wsp<bf16>(F, WS_KVM), 1024, 0};
          pg8::gemm_phase<pg8::EpiStore, pg8::StaticOrder, true, true>(ring, g, So, E); }
    } SEAM(3);
    if (IN(4)) {
#ifdef SEQ_SCAN
      for (int rep = 0; rep < REPS(4); ++rep) {
        if (F.bid < SCAN_ITEMS) { rwkv_scan_item(F, args, F.bid); }
        attn_queue_phase<0, -1>(F, ctl + CW_Q0 + 256 * rep);
        REPBAR(4); }
#else
        { LAS float* kt_ = (LAS float*)(F.lds + CK_TBL); for (int i_ = F.tid; i_ < 1024; i_ += NTHR) kt_[i_] = i_ < 512 ? kin(9)[i_] : kin(10)[i_ - 512]; __syncthreads(); }
        for (int rep = 0; rep < REPS(4); ++rep) { if (rep) xcd_barrier(bar); { const int t_ = F.tid >> 3, k8_ = (F.tid & 7) * 8; CkRaw ra, rb; int it = F.bid;
            if (it < CK_ITEMS) ck_load(ra, wsp<bf16>(F, WS_RKV), wsp<bf16>(F, WS_EW), wsp<bf16>(F, WS_AA), (size_t)(it >> 10) * S + (it & 127) * 64 + t_, ((it >> 7) & 7) * 64 + k8_);
            for (; it < CK_ITEMS; it += 2 * F.G) { rwkv_chunk_prep(F, it, ra, rb, it + F.G); if (it + F.G < CK_ITEMS) rwkv_chunk_prep(F, it + F.G, rb, ra, it + 2 * F.G); } } }
#endif
    } SEAM(4);
#ifdef SEQ_SCAN
    if (IN(5)) { PDUP(5, p5_rwkv_post(F, args)); } SEAM(5);
#else
    if (IN(5)) { if (F.bid < NB * NH) { rwkv_chunk_scan(F, F.bid); if (PROBE_DUP == 105) rwkv_chunk_scan(F, F.bid); } attn_queue_phase<0, -1>(F, ctl + CW_Q0); if (PROBE_DUP == 205) { xcd_barrier(bar); attn_queue_phase<0, -1>(F, ctl + CW_Q0 + 256); } } SEAM(5);
#endif
    if (IN(6)) { pg8::Gemm g{wsp<bf16>(F, WS_YMIX), wsp<bf16>(F, WS_WOUT0), T, D, D}; pg8::StaticOrder So; So.init(T, D, F.G, F.bid); pg8::EpiResidT<false, true> E{kin(0), wsp<bf16>(F, WS_HB)};
        pg8::gemm_phase<pg8::EpiResidT<false, true>, pg8::StaticOrder, true, true>(ring, g, So, E); } SEAM(6);
    if (IN(7)) { PDUP(7, p_norm(F, kin(19))); } SEAM(7);
    if (IN(8)) for (int rep = 0; rep < REPS(8); ++rep) { if (rep) xcd_barrier(bar); pg8::Gemm g{wsp<bf16>(F, WS_XNF), wsp<bf16>(F, WS_WGU0), T, 2 * DFF, D}; pg8::StaticOrder So; So.init(T, 2 * DFF, F.G, F.bid); pg8::EpiSwiGLU E{wsp<bf16>(F, WS_HID), DFF, nullptr, 0.f};
        pg8::gemm_phase<pg8::EpiSwiGLU, pg8::StaticOrder, true, true>(ring, g, So, E); } SEAM(8);
    if (IN(9)) { pg8::Gemm g{wsp<bf16>(F, WS_HID), wsp<bf16>(F, WS_WD0), T, D, DFF}; pg8::StaticOrder So; So.init(T, D, F.G, F.bid); pg8::EpiResidT<true, true> E{wsp<bf16>(F, WS_HB), wsp<bf16>(F, WS_HB)};
        pg8::gemm_phase<pg8::EpiResidT<true, true>, pg8::StaticOrder, true, true>(ring, g, So, E); } SEAM(9);
    if (IN(10)) { PDUP(10, p9_norm_logf(F, args)); } SEAM(10);
    if (IN(11)) { pg8::Gemm g{wsp<bf16>(F, WS_XNL1), wsp<bf16>(F, WS_WIN1), T, IN1P, D}; pg8::StaticOrder So; So.init(T, IN1P, F.G, F.bid); pg8::EpiStore E{wsp<bf16>(F, WS_PROJ1), IN1P, 0};
        pg8::gemm_phase<pg8::EpiStore, pg8::StaticOrder, true, true>(ring, g, So, E); } SEAM(11);
    if (IN(12)) { p11_dcum(F); p11_knorm(F); p11_moba_rope(F); } SEAM(12);
    if (IN(13)) { p13_moba_select(F); } SEAM(13);
    if (IN(14)) { layer1_attn_phase(F, ctl + CW_Q1); xcd_barrier(bar); p14_moba_combine(F); } SEAM(14);
    if (IN(15)) { pg8::Gemm g{wsp<bf16>(F, WS_YMIX), wsp<bf16>(F, WS_WOUT1), T, D, D}; pg8::StaticOrder So; So.init(T, D, F.G, F.bid); pg8::EpiResidT<true, true> E{wsp<bf16>(F, WS_HB), wsp<bf16>(F, WS_HB)};
        pg8::gemm_phase<pg8::EpiResidT<true, true>, pg8::StaticOrder, true, true>(ring, g, So, E); } SEAM(15);
    if (IN(16)) { p14_norm_route(F, args); } SEAM(16);
    if (IN(17)) { PDUP(17, p15_gather_convert(F, args)); } SEAM(17);
#pragma unroll 1
    for (int p = 0; p < MOE_NPASS; ++p) {
        const int ph = 18 + 2 * p;
        const int* TLE = wsp<int>(F, WS_TILEE);
        int ntp = 0, nx = 0; if (IN(ph) || IN(ph + 1)) { const int nt = __builtin_amdgcn_readfirstlane(TLE[512]); ntp = nt - p * MOE_PASS_TILES; ntp = ntp < 0 ? 0 : ntp;
            if (p < MOE_NPASS - 1) { ntp = ntp > MOE_PASS_TILES ? MOE_PASS_TILES : ntp; } else { nx = ntp > MOE_PASS_TILES ? ntp - MOE_PASS_TILES : 0; ntp -= nx; } }
        if (IN(ph) && ntp > 0) for (int rep = 0; rep < ((PROBE_DUP == 18 && p == 0) ? 2 : 1); ++rep) { if (rep) xcd_barrier(bar); pg8::Gemm g{wsp<bf16>(F, WS_XG8), wsp<bf16>(F, WS_WMOE_GU), XG_ROWS, 2 * DE, D / 2};
            pg8::MoeOrderAll So{TLE, ntp + nx, 2 * DE / 256, F.G, F.bid};
            pg8::EpiSwiGLU8 E{wsp<unsigned char>(F, WS_HIDM)}; pg8::gemm_phase<pg8::EpiSwiGLU8, pg8::MoeOrderAll, true, true, true>(ring, g, So, E); }
        SEAM(ph);
        if (IN(ph + 1) && ntp > 0) { pg8::Gemm g{wsp<bf16>(F, WS_HIDM), wsp<bf16>(F, WS_WMOE_D), MOE_HID_TILES * 256, D, DE / 2};
            pg8::MoeOrderAll So{TLE, ntp, D / 256, F.G, F.bid};
            pg8::EpiStoreSc E{wsp<bf16>(F, WS_XG), 0}; pg8::gemm_phase<pg8::EpiStoreSc, pg8::MoeOrderAll, true, true, true>(ring, g, So, E);
            if (nx > 0) { __syncthreads(); pg8::Gemm g2{wsp<bf16>(F, WS_HIDM), wsp<bf16>(F, WS_WMOE_D), MOE_HID_TILES * 256, D, DE / MOE_KSPLIT / 2, DE / 2};
                pg8::MoeOrder So2{TLE, p * MOE_PASS_TILES, nx, D / 256, F.G, F.bid, true, MOE_PASS_TILES, MOE_KSPLIT, DE / MOE_KSPLIT / 2};
                pg8::EpiStoreSc E2{wsp<bf16>(F, WS_YP) - (size_t)(MOE_NPASS * MOE_PASS_TILES) * 256 * D, (size_t)MOE_XTILES * 256 * D};
                pg8::gemm_phase<pg8::EpiStoreSc, pg8::MoeOrder, true, true, true>(ring, g2, So2, E2); } }
        SEAM(ph + 1);
    }
    if (IN(26)) { p_final(F, args); }
#undef IN
#undef SEAM
}

extern "C" void kernel_launch(void* const* d_in, const int* in_sizes, int n_in, void* d_out, int out_size, void* d_ws, size_t ws_size, hipStream_t stream) {
    static int grid = 0;
    if (grid == 0) {
        if (n_in != 33 || in_sizes[0] != T * D || out_size != T * D || ws_size < WS_END) { fprintf(stderr, "kernel_launch: unexpected shapes (n_in %d, in0 %d, out %d, ws %zu); nothing launched\n", n_in, n_in > 0 ? in_sizes[0] : -1, out_size, ws_size); grid = -1; return; }
        int dev = 0, cus = 0, per_cu = 0;
        if (hipGetDevice(&dev) != hipSuccess || hipDeviceGetAttribute(&cus, hipDeviceAttributeMultiprocessorCount, dev) != hipSuccess) { grid = -1; return; }
        if (hipFuncSetAttribute((const void*)hybrid_fwd, hipFuncAttributeMaxDynamicSharedMemorySize, LDS_BYTES) != hipSuccess) { fprintf(stderr, "kernel_launch: hipFuncSetAttribute failed\n"); grid = -1; return; }
        if (hipOccupancyMaxActiveBlocksPerMultiprocessor(&per_cu, (const void*)hybrid_fwd, NTHR, LDS_BYTES) != hipSuccess || per_cu < 1) fprintf(stderr, "kernel_launch: occupancy query reports %d\n", per_cu);
        (void)hipGetLastError();
        grid = cus;
    }
    if (grid < 0) return;
    if (hipMemsetAsync((char*)d_ws + WS_CTL, 0, CTL_ZERO_BYTES, stream) != hipSuccess) return;
    Args a{};
    for (int i = 0; i < 33; ++i) a.in[i] = (const float*)d_in[i];
    a.out = (float*)d_out; a.ws = (unsigned char*)d_ws;
#if MK_N_LAUNCHES == 1
    a.ph_lo = 0; a.ph_hi = N_PHASES + 1;
    hipLaunchKernelGGL(hybrid_fwd, dim3(grid), dim3(NTHR), LDS_BYTES, stream, a);
#else
    for (int ph = 0; ph <= N_PHASES; ++ph) { a.ph_lo = ph; a.ph_hi = ph + 1; hipLaunchKernelGGL(hybrid_fwd, dim3(grid), dim3(NTHR), LDS_BYTES, stream, a); }
#endif
}
```

```cpp
#include <hip/hip_runtime.h>
#include <cstdio>
#include <cstdint>
#include <cmath>
namespace pg8 {
#define PG8_LAS __attribute__((address_space(3)))
typedef unsigned short bf16_t;
typedef short bf16x8 __attribute__((ext_vector_type(8)));
typedef float f32x4 __attribute__((ext_vector_type(4)));
typedef unsigned u32x4 __attribute__((ext_vector_type(4)));
constexpr int BM = 256, BK = 64, HALF = 128, HTB = HALF * BK * 2  , STAGE_BYTES = 8 * HTB, NXCD = 8, WGM = 8;

__host__ __device__ __forceinline__ int lds_byte(int r, int c) { const int st = (r >> 4) * 2 + (c >> 5), rr = r & 15, cc = c & 31, ob = rr * 64 + cc * 2; return st * 1024 + (ob ^ (((ob >> 9) & 1) << 5)); }
__host__ __device__ __forceinline__ void stage_rc(int b, int& R, int& C) { const int st = b / 1024, sb = b % 1024, swz = sb ^ (((sb >> 9) & 1) << 5); R = (st >> 1) * 16 + swz / 64; C = (st & 1) * 32 + (swz % 64) / 2; }
__host__ __device__ __forceinline__ int perm32(int rho) { const int n = rho >> 4, i = rho & 15; return 8 * (i >> 2) + 4 * n + (i & 3); }

struct Unit { int pm, pn, om, on, koff, os; };
struct Gemm { const bf16_t* A; const bf16_t* Bt; int M, N, K, ld; };

struct StaticOrder {
    int nM, nN, nwg, G, c;
    __host__ __device__ void init(int M, int N, int G_, int c_) { nM = M / BM; nN = N / BM; nwg = nM * nN; G = G_; c = c_; }
    __host__ __device__ bool next(int i, Unit& u) const {
        const long L = (long)i * G + c; if (L >= nwg) return false;
        int wgid = (int)L; { const int q = nwg / NXCD, r = nwg % NXCD, xcd = wgid % NXCD, off = wgid / NXCD; wgid = (xcd < r ? xcd * (q + 1) : r * (q + 1) + (xcd - r) * q) + off; }
        const int nig = WGM * nN, gid = wgid / nig, fm = gid * WGM, gsz = (nM - fm) < WGM ? (nM - fm) : WGM;
        u.pm = fm + ((wgid % nig) % gsz); u.pn = (wgid % nig) / gsz; u.om = u.pm; u.on = u.pn; u.koff = 0; u.os = 0; return true;
    }
    __device__ __forceinline__ void a_ready(const Unit&) const {}
    __device__ __forceinline__ void done(const Unit&) const {}
};

__device__ __forceinline__ unsigned cvt_pk_bf16(float lo, float hi) { unsigned r; asm volatile("v_cvt_pk_bf16_f32 %0, %1, %2" : "=v"(r) : "v"(lo), "v"(hi)); return r; }
typedef float f32x2 __attribute__((ext_vector_type(2)));
__device__ __forceinline__ float sigmoid_f(float x) { return __builtin_amdgcn_rcpf(1.0f + __expf(-x)); }
__device__ __forceinline__ f32x2 swiglu2(f32x2 g, f32x2 u, float k0, float k1, float k2) {
    const f32x2 t = __builtin_elementwise_fma(g, (f32x2){k0, k0}, (f32x2){k1, k1}); f32x2 r; r[0] = __builtin_amdgcn_rcpf(k2 + __builtin_amdgcn_exp2f(t[0])); r[1] = __builtin_amdgcn_rcpf(k2 + __builtin_amdgcn_exp2f(t[1]));
    return (g * u) * r;
}
#define PG8_LO2(v) __builtin_shufflevector(v, v, 0, 1)
#define PG8_HI2(v) __builtin_shufflevector(v, v, 2, 3)
struct EpiStore {
    static constexpr bool PERM = true, AFTER_DRAIN = false;
    bf16_t* O; int ldc; size_t slab;
    __device__ __forceinline__ void operator()(const f32x4 (&acc)[2][2][4][2], const Unit& u, int wr, int wc, int fr, int fq) const {
        const int row0 = u.om * BM + wr * 64 + fr, col0 = u.on * BM + wc * 32 + 8 * fq;
#pragma unroll
        for (int ai = 0; ai < 2; ++ai)
#pragma unroll
            for (int m = 0; m < 4; ++m) { bf16_t* rowp = O + (size_t)u.os * slab + (size_t)(row0 + ai * HALF + m * 16) * ldc + col0;
#pragma unroll
                for (int bj = 0; bj < 2; ++bj) { const f32x4 v0 = acc[ai][bj][m][0], v1 = acc[ai][bj][m][1];
                    u32x4 w; w.x = cvt_pk_bf16(v0[0], v0[1]); w.y = cvt_pk_bf16(v0[2], v0[3]); w.z = cvt_pk_bf16(v1[0], v1[1]); w.w = cvt_pk_bf16(v1[2], v1[3]);
                    *(u32x4*)(rowp + bj * HALF) = w; } }
    }
};
struct EpiLora {
    static constexpr bool PERM = true, AFTER_DRAIN = false;
    bf16_t* EW; const float* w0; const float* a0;
    __device__ __forceinline__ void operator()(const f32x4 (&acc)[2][2][4][2], const Unit& u, int wr, int wc, int fr, int fq) const {
        const int kind = u.on >> 1; bf16_t* O = EW + (size_t)kind * (16u << 20); const float* bias = kind == 0 ? w0 : a0;
        const int row0 = u.om * BM + wr * 64 + fr, col0 = (u.on & 1) * BM + wc * 32 + 8 * fq;
        f32x4 bq[2][2];
#pragma unroll
        for (int bj = 0; bj < 2; ++bj) { bq[bj][0] = *(const f32x4*)(bias + col0 + bj * HALF); bq[bj][1] = *(const f32x4*)(bias + col0 + bj * HALF + 4); }
#pragma unroll
        for (int ai = 0; ai < 2; ++ai)
#pragma unroll
            for (int m = 0; m < 4; ++m) { bf16_t* rowp = O + (size_t)(row0 + ai * HALF + m * 16) * 512 + col0;
#pragma unroll
                for (int bj = 0; bj < 2; ++bj) { f32x4 v0 = acc[ai][bj][m][0], v1 = acc[ai][bj][m][1];
                    if (kind < 2) { const float sc = kind == 0 ? 0.60653066f : 1.0f; const f32x4 b0 = bq[bj][0], b1 = bq[bj][1];
#pragma unroll
                        for (int e = 0; e < 4; ++e) { v0[e] = sc * sigmoid_f(v0[e] + b0[e]); v1[e] = sc * sigmoid_f(v1[e] + b1[e]); } }
                    u32x4 w; w.x = cvt_pk_bf16(v0[0], v0[1]); w.y = cvt_pk_bf16(v0[2], v0[3]); w.z = cvt_pk_bf16(v1[0], v1[1]); w.w = cvt_pk_bf16(v1[2], v1[3]);
                    *(u32x4*)(rowp + bj * HALF) = w; asm volatile("" ::: "memory"); } }
    }
};
struct EpiResid {
    static constexpr bool PERM = true, AFTER_DRAIN = false;
    const float* base; float* out; int ldc; bf16_t* xn; float* ssq;
    __device__ __forceinline__ void operator()(const f32x4 (&acc)[2][2][4][2], const Unit& u, int wr, int wc, int fr, int fq) const {
        const int row0 = u.om * BM + wr * 64 + fr, col0 = u.on * BM + wc * 32 + 8 * fq;
#pragma unroll
        for (int ai = 0; ai < 2; ++ai)
#pragma unroll
            for (int m = 0; m < 4; ++m) { const int row = row0 + ai * HALF + m * 16; const size_t off = (size_t)row * ldc + col0; float ss = 0.f;
#pragma unroll
                for (int bj = 0; bj < 2; ++bj) { const f32x4 b0 = *(const f32x4*)(base + off + bj * HALF), b1 = *(const f32x4*)(base + off + bj * HALF + 4);
                    const f32x4 o0 = b0 + acc[ai][bj][m][0], o1 = b1 + acc[ai][bj][m][1];
                    *(f32x4*)(out + off + bj * HALF) = o0; *(f32x4*)(out + off + bj * HALF + 4) = o1;
                    if (xn) { u32x4 w; w.x = cvt_pk_bf16(o0[0], o0[1]); w.y = cvt_pk_bf16(o0[2], o0[3]); w.z = cvt_pk_bf16(o1[0], o1[1]); w.w = cvt_pk_bf16(o1[2], o1[3]); *(u32x4*)(xn + off + bj * HALF) = w;
                        ss += (o0[0] * o0[0] + o0[1] * o0[1]) + (o0[2] * o0[2] + o0[3] * o0[3]) + (o1[0] * o1[0] + o1[1] * o1[1]) + (o1[2] * o1[2] + o1[3] * o1[3]); } }
                if (xn) { ss += __shfl_xor(ss, 16); ss += __shfl_xor(ss, 32); if (fq == 0) ssq[(size_t)row * 16 + u.on * 4 + wc] = ss; } }
    }
};
template <bool IN_BF, bool OUT_BF> struct EpiResidT {
    static constexpr bool PERM = true, AFTER_DRAIN = false;
    const void* base; void* out; static constexpr int ldc = 1024;
    __device__ __forceinline__ void operator()(const f32x4 (&acc)[2][2][4][2], const Unit& u, int wr, int wc, int fr, int fq) const {
        const int row0 = u.om * BM + wr * 64 + fr, col0 = u.on * BM + wc * 32 + 8 * fq;
#pragma unroll
        for (int ai = 0; ai < 2; ++ai) { f32x4 bb[4][2][2];
#pragma unroll
            for (int m = 0; m < 4; ++m) { const size_t off = (size_t)(row0 + ai * HALF + m * 16) * ldc + col0;
#pragma unroll
                for (int bj = 0; bj < 2; ++bj) {
                    if constexpr (IN_BF) { const u32x4 w = *(const u32x4*)((const bf16_t*)base + off + bj * HALF);
                        bb[m][bj][0] = (f32x4){__builtin_bit_cast(float, w.x << 16), __builtin_bit_cast(float, w.x & 0xffff0000u), __builtin_bit_cast(float, w.y << 16), __builtin_bit_cast(float, w.y & 0xffff0000u)};
                        bb[m][bj][1] = (f32x4){__builtin_bit_cast(float, w.z << 16), __builtin_bit_cast(float, w.z & 0xffff0000u), __builtin_bit_cast(float, w.w << 16), __builtin_bit_cast(float, w.w & 0xffff0000u)}; }
                    else { bb[m][bj][0] = *(const f32x4*)((const float*)base + off + bj * HALF); bb[m][bj][1] = *(const f32x4*)((const float*)base + off + bj * HALF + 4); } } }
#pragma unroll
            for (int m = 0; m < 4; ++m) { const size_t off = (size_t)(row0 + ai * HALF + m * 16) * ldc + col0;
#pragma unroll
                for (int bj = 0; bj < 2; ++bj) { const f32x4 o0 = bb[m][bj][0] + acc[ai][bj][m][0], o1 = bb[m][bj][1] + acc[ai][bj][m][1];
                    if constexpr (OUT_BF) { u32x4 w; w.x = cvt_pk_bf16(o0[0], o0[1]); w.y = cvt_pk_bf16(o0[2], o0[3]); w.z = cvt_pk_bf16(o1[0], o1[1]); w.w = cvt_pk_bf16(o1[2], o1[3]); *(u32x4*)((bf16_t*)out + off + bj * HALF) = w; }
                    else { *(f32x4*)((float*)out + off + bj * HALF) = o0; *(f32x4*)((float*)out + off + bj * HALF + 4) = o1; } } } }
    }
};
struct EpiSwiGLU {
    static constexpr bool PERM = true, AFTER_DRAIN = false;
    bf16_t* O; int ldc; const float* ssq; float eps;
    __device__ __forceinline__ void operator()(const f32x4 (&acc)[2][2][4][2], const Unit& u, int wr, int wc, int fr, int fq) const {
        const int row0 = u.om * BM + wr * 64 + fr, col0 = u.on * HALF + wc * 32 + 8 * fq;
#pragma unroll
        for (int ai = 0; ai < 2; ++ai)
#pragma unroll
            for (int m = 0; m < 4; ++m) { const int row = row0 + ai * HALF + m * 16; bf16_t* rowp = O + (size_t)row * ldc + col0; float rs = 1.0f;
                if (ssq) { const f32x4* sp = (const f32x4*)(ssq + (size_t)row * 16); const f32x4 s0 = sp[0], s1 = sp[1], s2 = sp[2], s3 = sp[3];
                    const float t = ((s0[0] + s0[1]) + (s0[2] + s0[3])) + ((s1[0] + s1[1]) + (s1[2] + s1[3])) + ((s2[0] + s2[1]) + (s2[2] + s2[3])) + ((s3[0] + s3[1]) + (s3[2] + s3[3]));
                    rs = __builtin_amdgcn_rsqf(t * (1.0f / 1024.0f) + eps); }
                const float k0 = -1.44269504f * rs, k2 = 1.0f / (rs * rs), k1 = ssq ? __builtin_amdgcn_logf(k2) : 0.0f;
                const f32x2 ha = swiglu2(PG8_LO2(acc[ai][0][m][0]), PG8_LO2(acc[ai][1][m][0]), k0, k1, k2), hb = swiglu2(PG8_HI2(acc[ai][0][m][0]), PG8_HI2(acc[ai][1][m][0]), k0, k1, k2);
                const f32x2 hc = swiglu2(PG8_LO2(acc[ai][0][m][1]), PG8_LO2(acc[ai][1][m][1]), k0, k1, k2), hd = swiglu2(PG8_HI2(acc[ai][0][m][1]), PG8_HI2(acc[ai][1][m][1]), k0, k1, k2);
                u32x4 w; w.x = cvt_pk_bf16(ha[0], ha[1]); w.y = cvt_pk_bf16(hb[0], hb[1]); w.z = cvt_pk_bf16(hc[0], hc[1]); w.w = cvt_pk_bf16(hd[0], hd[1]);
                *(u32x4*)rowp = w; }
    }
};
constexpr float F8_SX = 16.0f, F8_SW1 = 256.0f, F8_SH = 8.0f, F8_SW2 = 512.0f;
__device__ __forceinline__ float sat8(float x) { return __builtin_amdgcn_fmed3f(x, -448.0f, 448.0f); }
__device__ __forceinline__ unsigned pk4_fp8(float a, float b, float c, float d) { int w = __builtin_amdgcn_cvt_pk_fp8_f32(sat8(a), sat8(b), 0, false); w = __builtin_amdgcn_cvt_pk_fp8_f32(sat8(c), sat8(d), w, true); return (unsigned)w; }
struct EpiSwiGLU8 {
    static constexpr bool PERM = true, AFTER_DRAIN = false;
    unsigned char* O; static constexpr int ldc = 3584; static constexpr float sin = 1.0f / (F8_SX * F8_SW1), sout = F8_SH;
    __device__ __forceinline__ void operator()(const f32x4 (&acc)[2][2][4][2], const Unit& u, int wr, int wc, int fr, int fq) const {
        const int row0 = u.om * BM + wr * 64 + fr, col0 = u.on * HALF + wc * 32 + 8 * fq;
#pragma unroll
        for (int ai = 0; ai < 2; ++ai)
#pragma unroll
            for (int m = 0; m < 4; ++m) { const int row = row0 + ai * HALF + m * 16; unsigned char* rowp = O + (size_t)row * ldc + col0;
                constexpr float c = sin * sin * sout, k0 = -1.44269504f * sin, k2 = 1.0f / c, k1 = 21.0f; static_assert(k2 == 2097152.0f, "k1 = log2(1 / c)");
                const f32x2 ha = swiglu2(PG8_LO2(acc[ai][0][m][0]), PG8_LO2(acc[ai][1][m][0]), k0, k1, k2), hb = swiglu2(PG8_HI2(acc[ai][0][m][0]), PG8_HI2(acc[ai][1][m][0]), k0, k1, k2);
                const f32x2 hc = swiglu2(PG8_LO2(acc[ai][0][m][1]), PG8_LO2(acc[ai][1][m][1]), k0, k1, k2), hd = swiglu2(PG8_HI2(acc[ai][0][m][1]), PG8_HI2(acc[ai][1][m][1]), k0, k1, k2);
                f32x2 w; unsigned w0 = pk4_fp8(ha[0], ha[1], hb[0], hb[1]), w1 = pk4_fp8(hc[0], hc[1], hd[0], hd[1]); w[0] = __builtin_bit_cast(float, w0); w[1] = __builtin_bit_cast(float, w1);
                *(f32x2*)rowp = w; }
    }
};
struct EpiStoreSc {
    static constexpr bool PERM = true, AFTER_DRAIN = false;
    bf16_t* O; size_t slab; static constexpr int ldc = 1024; static constexpr float sc = 1.0f / (F8_SH * F8_SW2);
    __device__ __forceinline__ void operator()(const f32x4 (&acc)[2][2][4][2], const Unit& u, int wr, int wc, int fr, int fq) const {
        const int row0 = u.om * BM + wr * 64 + fr, col0 = u.on * BM + wc * 32 + 8 * fq;
#pragma unroll
        for (int ai = 0; ai < 2; ++ai)
#pragma unroll
            for (int m = 0; m < 4; ++m) { bf16_t* rowp = O + (size_t)u.os * slab + (size_t)(row0 + ai * HALF + m * 16) * ldc + col0;
#pragma unroll
                for (int bj = 0; bj < 2; ++bj) { const f32x4 v0 = acc[ai][bj][m][0] * sc, v1 = acc[ai][bj][m][1] * sc;
                    u32x4 w; w.x = cvt_pk_bf16(v0[0], v0[1]); w.y = cvt_pk_bf16(v0[2], v0[3]); w.z = cvt_pk_bf16(v1[0], v1[1]); w.w = cvt_pk_bf16(v1[2], v1[3]);
                    *(u32x4*)(rowp + bj * HALF) = w; } }
    }
};
struct MoeOrder {
    const int* tile_e; int rt0, ntp, nbn, G, c; bool a_local;
    int lt0, nsplit, klen;
    __device__ __forceinline__ bool next(int i, Unit& u) const {
        const long L = (long)i * G + c; if (L >= (long)ntp * nbn * nsplit) return false;
        const int j = (int)(L % nsplit), q = (int)(L / nsplit), pn = q / ntp, lt = lt0 + q % ntp, rt = rt0 + lt; const int e = __builtin_amdgcn_readfirstlane(tile_e[rt]);
        u.pm = a_local ? lt : rt; u.pn = e * nbn + pn; u.om = a_local ? rt : lt; u.on = pn; u.koff = j * klen; u.os = j; return true;
    }
    __device__ __forceinline__ void a_ready(const Unit&) const {}
    __device__ __forceinline__ void done(const Unit&) const {}
};
struct MoeOrderAll {
    const int* tile_e; int nt, nbn, G, c;
    __device__ __forceinline__ bool next(int i, Unit& u) const {
        const int L = i * G + c; if (L >= nt * nbn) return false;
        const int nf = nt >> 6, per = 64 * nbn; int g = L / per; g = g < nf ? g : nf;
        const int r = L - g * per, gt = g < nf ? 64 : nt - 64 * nf; int pn = r / gt, rt = 64 * g + r % gt;
        if (G == 256 && g < nf && (nbn & 3) == 0) {
            const int rr = r >> 8, cc = r & 255, sl = cc >> 3; pn = 4 * rr + (sl >> 3); rt = 64 * g + 8 * (cc & 7) + (sl & 7); }
        const int e = __builtin_amdgcn_readfirstlane(tile_e[rt]);
        u.pm = rt; u.pn = e * nbn + pn; u.om = rt; u.on = pn; u.koff = 0; u.os = 0; return true;
    }
    __device__ __forceinline__ void a_ready(const Unit&) const {}
    __device__ __forceinline__ void done(const Unit&) const {}
};
typedef int i32x8 __attribute__((ext_vector_type(8)));
typedef int i32x4 __attribute__((ext_vector_type(4)));
__device__ __forceinline__ i32x8 cat8(bf16x8 a, bf16x8 b) { const i32x4 x = __builtin_bit_cast(i32x4, a), y = __builtin_bit_cast(i32x4, b); return __builtin_shufflevector(x, y, 0, 1, 2, 3, 4, 5, 6, 7); }
__device__ __forceinline__ void mfma_fp8(f32x4& c, const i32x8 a, const i32x8 b) { asm volatile("v_mfma_f32_16x16x128_f8f6f4 %0, %1, %2, %0" : "+v"(c) : "v"(a), "v"(b)); }
template <class Epi, class Sched, bool ALIGN_EPI = false, bool SP2 = false, bool F8 = false>
__device__ __forceinline__ void gemm_phase(PG8_LAS unsigned char* lds, const Gemm g, const Sched& S, const Epi& E) {
    int tid_ = threadIdx.x; asm volatile("" : "+v"(tid_));
    const int tid = tid_, wid = __builtin_amdgcn_readfirstlane(tid >> 6), lane = tid & 63, wr = wid >> 2, wc = wid & 3, fr = lane & 15, fq = lane >> 4;
    const int K = g.K, nt = K / BK, LD = g.ld ? g.ld : g.K;
    unsigned voffA[2], voffB[2];
#pragma unroll
    for (int i = 0; i < 2; ++i) { int R, C; stage_rc(tid * 16 + i * 8192, R, C); const int Rb = Epi::PERM ? ((R & ~31) + perm32(R & 31)) : R;
        voffA[i] = (unsigned)(R * LD + C) * 2u; voffB[i] = (unsigned)(Rb * LD + C) * 2u; }
    const size_t kstep = (size_t)(BK * 2);
    const size_t hstep = (size_t)HALF * LD * 2;
    const size_t tstep = 2 * hstep;
    const unsigned ldsw = (unsigned)wid * 1024u;
    const int aoff = lds_byte(wr * 64 + fr, fq * 8), boff = lds_byte(wc * 32 + fr, fq * 8);
#define PG8_SA(b, h) (((b) * 2 + (h)) * HTB)
#define PG8_SB(b, h) ((4 + (b) * 2 + (h)) * HTB)
#define PG8_STAGE(bufoff, gbase, voff) do { _Pragma("unroll") for (int _i = 0; _i < 2; ++_i) \
        __builtin_amdgcn_global_load_lds((const unsigned*)((const char*)(gbase) + (voff)[_i]), (PG8_LAS unsigned*)(lds + (bufoff) + ldsw + _i * 8192), 16, 0, 0); } while (0)
#define PG8_LDA(dst, b, h) do { _Pragma("unroll") for (int m = 0; m < 4; ++m) _Pragma("unroll") for (int k = 0; k < 2; ++k) dst[m][k] = *(const PG8_LAS bf16x8*)(lds + PG8_SA(b, h) + aoff + m * 2048 + k * 1024); } while (0)
#define PG8_LDB(dst, b, h) do { _Pragma("unroll") for (int n = 0; n < 2; ++n) _Pragma("unroll") for (int k = 0; k < 2; ++k) dst[n][k] = *(const PG8_LAS bf16x8*)(lds + PG8_SB(b, h) + boff + n * 2048 + k * 1024); } while (0)
#define PG8_MMA(ai, bj, At, Bt) do { __builtin_amdgcn_s_setprio(1); _Pragma("unroll") for (int m = 0; m < 4; ++m) _Pragma("unroll") for (int n = 0; n < 2; ++n) { \
        if constexpr (F8) mfma_fp8(acc[ai][bj][m][n], cat8(Bt[n][0], Bt[n][1]), cat8(At[m][0], At[m][1])); \
        else { _Pragma("unroll") for (int k = 0; k < 2; ++k) acc[ai][bj][m][n] = __builtin_amdgcn_mfma_f32_16x16x32_bf16(Bt[n][k], At[m][k], acc[ai][bj][m][n], 0, 0, 0); } } __builtin_amdgcn_s_setprio(0); } while (0)
#define PG8_WAIT_V(n) asm volatile("s_waitcnt vmcnt(" #n ")" ::: "memory")
#define PG8_WAIT_L(n) asm volatile("s_waitcnt lgkmcnt(" #n ")" ::: "memory")
#define PG8_BAR __builtin_amdgcn_s_barrier()
#define PG8_SCHED __builtin_amdgcn_sched_barrier(0)
    Unit cur, nxt; int ui = 0;
    if (!S.next(0, cur)) return;
    f32x4 acc[2][2][4][2];
#pragma unroll
    for (int a = 0; a < 2; ++a)
#pragma unroll
        for (int b = 0; b < 2; ++b)
#pragma unroll
            for (int m = 0; m < 4; ++m)
#pragma unroll
                for (int n = 0; n < 2; ++n) acc[a][b][m][n] = (f32x4){0.f, 0.f, 0.f, 0.f};
    bf16x8 At[4][2], B0[2][2], B1[2][2];
    const char* cA = (const char*)g.A + (size_t)cur.pm * tstep + (size_t)cur.koff * 2; const char* cB = (const char*)g.Bt + (size_t)cur.pn * tstep + (size_t)cur.koff * 2;
    S.a_ready(cur);
    if constexpr (SP2) {
        PG8_STAGE(PG8_SB(0, 0), cB, voffB); PG8_STAGE(PG8_SB(0, 1), cB + hstep, voffB); PG8_STAGE(PG8_SA(0, 0), cA, voffA); PG8_STAGE(PG8_SA(0, 1), cA + hstep, voffA);
        if (wr == 1) PG8_BAR;
        PG8_WAIT_V(2); PG8_BAR;
        PG8_STAGE(PG8_SB(1, 0), cB + kstep, voffB); PG8_STAGE(PG8_SA(1, 0), cA + kstep, voffA); PG8_STAGE(PG8_SB(1, 1), cB + hstep + kstep, voffB);
        PG8_WAIT_V(6); PG8_BAR;
    } else {
        PG8_STAGE(PG8_SB(0, 0), cB, voffB); PG8_STAGE(PG8_SA(0, 0), cA, voffA); PG8_STAGE(PG8_SB(0, 1), cB + hstep, voffB); PG8_STAGE(PG8_SA(0, 1), cA + hstep, voffA);
        if (wr == 1) PG8_BAR;
        PG8_WAIT_V(4); PG8_BAR;
        PG8_STAGE(PG8_SB(1, 0), cB + kstep, voffB); PG8_STAGE(PG8_SA(1, 0), cA + kstep, voffA); PG8_STAGE(PG8_SB(1, 1), cB + hstep + kstep, voffB);
        PG8_WAIT_V(6); PG8_BAR;
    }
    for (;;) {
        const bool has_next = S.next(ui + 1, nxt);
        const char* nA = has_next ? (const char*)g.A + (size_t)nxt.pm * tstep + (size_t)nxt.koff * 2 : cA; const char* nB = has_next ? (const char*)g.Bt + (size_t)nxt.pn * tstep + (size_t)nxt.koff * 2 : cB;
#pragma nounroll
        for (int t = 0; t < nt; t += 2) {
            const bool last = (t == nt - 2);
            const char* a1 = cA + (size_t)(t + 1) * kstep;
            const char* a2 = last ? nA : cA + (size_t)(t + 2) * kstep; const char* b2 = last ? nB : cB + (size_t)(t + 2) * kstep;
            const char* a3 = a2 + kstep; const char* b3 = b2 + kstep;
            if (last && has_next) S.a_ready(nxt);
            if constexpr (SP2) {
            PG8_LDB(B0, 0, 0); PG8_LDB(B1, 0, 1); PG8_SCHED; PG8_LDA(At, 0, 0); PG8_STAGE(PG8_SA(1, 1), a1 + hstep, voffA);
            PG8_WAIT_V(8); PG8_WAIT_L(0); PG8_BAR; PG8_MMA(0, 0, At, B0); PG8_MMA(0, 1, At, B1); PG8_BAR; PG8_SCHED;
            PG8_LDA(At, 0, 1); PG8_STAGE(PG8_SB(0, 0), b2, voffB); PG8_STAGE(PG8_SB(0, 1), b2 + hstep, voffB); PG8_STAGE(PG8_SA(0, 0), a2, voffA);
            PG8_WAIT_V(8); PG8_WAIT_L(0); PG8_BAR; PG8_MMA(1, 0, At, B0); PG8_MMA(1, 1, At, B1); PG8_BAR; PG8_SCHED;
            PG8_LDB(B0, 1, 0); PG8_LDB(B1, 1, 1); PG8_SCHED; PG8_LDA(At, 1, 0); PG8_STAGE(PG8_SA(0, 1), a2 + hstep, voffA);
            PG8_WAIT_V(8); PG8_WAIT_L(0); PG8_BAR; PG8_MMA(0, 0, At, B0); PG8_MMA(0, 1, At, B1); PG8_BAR; PG8_SCHED;
            PG8_LDA(At, 1, 1); PG8_STAGE(PG8_SB(1, 0), b3, voffB); PG8_STAGE(PG8_SB(1, 1), b3 + hstep, voffB); PG8_STAGE(PG8_SA(1, 0), a3, voffA);
            PG8_WAIT_V(8); PG8_WAIT_L(0); PG8_BAR; PG8_MMA(1, 0, At, B0); PG8_MMA(1, 1, At, B1); PG8_BAR; PG8_SCHED;
            } else {
            PG8_LDB(B0, 0, 0); PG8_SCHED; PG8_LDA(At, 0, 0); PG8_STAGE(PG8_SA(1, 1), a1 + hstep, voffA);
            PG8_WAIT_L(8); PG8_BAR; PG8_WAIT_L(0); PG8_MMA(0, 0, At, B0); PG8_BAR; PG8_SCHED;
            PG8_LDB(B1, 0, 1); PG8_STAGE(PG8_SB(0, 0), b2, voffB);
            PG8_BAR; PG8_WAIT_L(0); PG8_MMA(0, 1, At, B1); PG8_BAR;
            PG8_LDA(At, 0, 1); PG8_STAGE(PG8_SA(0, 0), a2, voffA);
            PG8_BAR; PG8_WAIT_L(0); PG8_MMA(1, 0, At, B0); PG8_BAR; PG8_SCHED;
            PG8_STAGE(PG8_SB(0, 1), b2 + hstep, voffB);
            PG8_WAIT_V(6); PG8_BAR; PG8_MMA(1, 1, At, B1); PG8_BAR;
            PG8_LDB(B0, 1, 0); PG8_SCHED; PG8_LDA(At, 1, 0); PG8_STAGE(PG8_SA(0, 1), a2 + hstep, voffA);
            PG8_WAIT_L(8); PG8_BAR; PG8_WAIT_L(0); PG8_MMA(0, 0, At, B0); PG8_BAR; PG8_SCHED;
            PG8_LDB(B1, 1, 1); PG8_STAGE(PG8_SB(1, 0), b3, voffB);
            PG8_BAR; PG8_WAIT_L(0); PG8_MMA(0, 1, At, B1); PG8_BAR;
            PG8_LDA(At, 1, 1); PG8_STAGE(PG8_SA(1, 0), a3, voffA);
            PG8_BAR; PG8_WAIT_L(0); PG8_MMA(1, 0, At, B0); PG8_BAR; PG8_SCHED;
            PG8_STAGE(PG8_SB(1, 1), b3 + hstep, voffB);
            PG8_WAIT_V(6); PG8_BAR; PG8_MMA(1, 1, At, B1); PG8_BAR;
            }
        }
        if constexpr (F8) {
#define PG8_A4(a, b) "+v"(acc[a][b][0][0]), "+v"(acc[a][b][0][1]), "+v"(acc[a][b][1][0]), "+v"(acc[a][b][1][1]), "+v"(acc[a][b][2][0]), "+v"(acc[a][b][2][1]), "+v"(acc[a][b][3][0]), "+v"(acc[a][b][3][1])
            asm volatile("s_nop 15\n\ts_nop 7" : PG8_A4(0, 0), PG8_A4(0, 1)); asm volatile("" : PG8_A4(1, 0), PG8_A4(1, 1));
#undef PG8_A4
        }
        if constexpr (ALIGN_EPI) { if (wr == 0) PG8_BAR; }
        if constexpr (!Epi::AFTER_DRAIN) { E(acc, cur, wr, wc, fr, fq); S.done(cur); }
        if (!has_next) break;
#pragma unroll
        for (int a = 0; a < 2; ++a)
#pragma unroll
            for (int b = 0; b < 2; ++b)
#pragma unroll
                for (int m = 0; m < 4; ++m)
#pragma unroll
                    for (int n = 0; n < 2; ++n) acc[a][b][m][n] = (f32x4){0.f, 0.f, 0.f, 0.f};
        cur = nxt; cA = nA; cB = nB; ++ui;
        if constexpr (ALIGN_EPI) { if (wr == 1) PG8_BAR; }
    }
    PG8_WAIT_V(0);
    if constexpr (!ALIGN_EPI) { if (wr == 0) PG8_BAR; }
    PG8_BAR;
    if constexpr (Epi::AFTER_DRAIN) { E.fused(acc, cur, wr, wc, fr, fq, lds, wid, lane); S.done(cur); }
#undef PG8_SA
#undef PG8_SB
#undef PG8_STAGE
#undef PG8_LDA
#undef PG8_LDB
#undef PG8_MMA
#undef PG8_WAIT_V
#undef PG8_WAIT_L
#undef PG8_BAR
#undef PG8_SCHED
}
}

constexpr int NWAVES = 8, NTHR = NWAVES * 64;
#ifndef MK_N_LAUNCHES
#define MK_N_LAUNCHES 1
#endif
constexpr int NB = 4, S = 8192, D = 1024, T = NB * S;
constexpr int NH = 8, HD = 64, GW = 512;
constexpr int IN0 = 2208, IN0P = 2304, RWC = 1792;
constexpr int C_R = 0, C_K = 512, C_V = 1024, C_WD = 1536, C_AD = 1600, C_GD = 1664, C_QL = 1792, C_KVL = 2048, C_KR = 2176;
constexpr int QR = 256, KVR = 128, ROPE_M = 32, MLA_QH = 96;
constexpr int DFF = 2816, IN1 = 3080, IN1P = 3072, NE = 8, DE = 3584;
constexpr int MOBA_BLK = 256, MOBA_NB = S / MOBA_BLK;
constexpr int XG_ROWS = 2 * T + NE * 256;
constexpr int MOE_PASS_TILES = 256, MOE_MAX_TILES = 264, MOE_NPASS = 1, MOE_XTILES = 8, MOE_HID_TILES = MOE_PASS_TILES + MOE_XTILES, MOE_KSPLIT = 7;
constexpr float NORM_EPS = 1e-6f, GN_EPS = 64e-5f;

constexpr size_t MiB = 1u << 20;
constexpr size_t WS_CTL = 0, CTL_ZERO_BYTES = 1 * MiB;
constexpr size_t WS_ROPE32 = 1 * MiB;
constexpr size_t WS_ROPE64 = 2 * MiB;
constexpr size_t WS_KPE = 4 * MiB;
constexpr size_t WS_LOGF = 6 * MiB;
constexpr size_t WS_DCUM = 7 * MiB;
constexpr size_t WS_SEL = 8 * MiB;
constexpr size_t WS_KMEAN = 9 * MiB;
constexpr size_t WS_TOPE = 10 * MiB;
constexpr size_t WS_TOPP = 10 * MiB + 512 * 1024;
constexpr size_t WS_TOPG = 11 * MiB;
constexpr size_t WS_PROW = 11 * MiB + 512 * 1024;
constexpr size_t WS_SSQ = 13 * MiB;
constexpr size_t WS_TILEE = 12 * MiB;
constexpr size_t WS_WIN0 = 16 * MiB;
constexpr size_t WS_WLORA = 21 * MiB;
constexpr size_t WS_WUQ = 22 * MiB;
constexpr size_t WS_WUKV = 23 * MiB;
constexpr size_t WS_WOUT0 = 24 * MiB;
constexpr size_t WS_WGU0 = 26 * MiB;
constexpr size_t WS_WD0 = 37 * MiB;
constexpr size_t WS_WIN1 = 43 * MiB;
constexpr size_t WS_WOUT1 = 49 * MiB;
constexpr size_t WS_XN = 52 * MiB;
constexpr size_t WS_HB = 52 * MiB;
constexpr size_t WS_XNF = 292 * MiB;
constexpr size_t WS_XNL1 = 308 * MiB;
constexpr size_t WS_KVM = WS_XN;
constexpr size_t WS_BIG = 116 * MiB;
constexpr size_t WS_PROJ0 = WS_BIG;
constexpr size_t WS_EW = WS_BIG, WS_AA = WS_BIG + 32 * MiB, WS_GG = WS_BIG + 64 * MiB;
constexpr size_t WS_QM = WS_BIG + 96 * MiB;
constexpr size_t WS_YRAW = WS_BIG + 144 * MiB;
constexpr size_t WS_HID = WS_BIG;
constexpr size_t WS_PROJ1 = WS_BIG;
constexpr size_t WS_LIN = 308 * MiB;
constexpr size_t WS_QN = 324 * MiB;
constexpr size_t WS_KVN = 340 * MiB;
constexpr size_t WS_RKV = 348 * MiB;
constexpr size_t WS_YMIX = 446 * MiB;
constexpr size_t WS_XN2 = WS_YMIX;
constexpr size_t WS_WMOE_GU = 116 * MiB;
constexpr size_t WS_WMOE_D = 16 * MiB;
constexpr size_t WS_XG = 116 * MiB;
constexpr size_t WS_HIDM = 248 * MiB;
constexpr size_t WS_XG8 = 172 * MiB;
using pg8::F8_SX; using pg8::F8_SW1; using pg8::F8_SH; using pg8::F8_SW2;
constexpr size_t WS_QLIST = 16 * MiB;
constexpr size_t WS_PARTO = 308 * MiB;
constexpr size_t WS_PARTML = 436 * MiB;
constexpr size_t WS_YP = 479 * MiB;
constexpr size_t WS_END = 510 * MiB;
static_assert(WS_WMOE_D + (size_t)NE * D * DE <= WS_HB && WS_HB + (size_t)T * D * 2 <= WS_WMOE_GU && WS_WMOE_GU + (size_t)NE * 2 * DE * D <= WS_XG8 && WS_XG8 + (size_t)XG_ROWS * 1024 <= WS_HIDM && WS_XG >= WS_WMOE_GU &&
              WS_XG + (size_t)XG_ROWS * 1024 * 2 <= WS_HIDM && WS_HIDM + (size_t)MOE_HID_TILES * 256 * DE <= WS_YP && WS_YP + (size_t)MOE_KSPLIT * MOE_XTILES * 256 * D * 2 <= WS_END && WS_XN2 >= WS_XG8 + (size_t)XG_ROWS * 1024, "MoE map (the bf16 residual stream WS_HB stays alive through it)");
static_assert(WS_YRAW + (size_t)T * 512 * 4 <= WS_QN && WS_RKV + (size_t)T * 1536 * 2 <= WS_YMIX && WS_QM + (size_t)T * 768 * 2 <= WS_YRAW, "layer-0 map");
constexpr int CW_BAR = 4096;
constexpr int CW_CNT = 16384;
constexpr int CW_MOBA = 32768;
constexpr int CW_Q0 = 16384 + 64, CW_Q1 = 16384 + 128;

constexpr int RING_OFF = 0, RING_BYTES = 131072;
constexpr int LDSCTL_OFF = RING_BYTES, MISC_OFF = LDSCTL_OFF + 320;
constexpr int LDS_BYTES = 147456;

#define GAS __attribute__((address_space(1)))
#define LAS __attribute__((address_space(3)))
typedef unsigned short bf16;
typedef unsigned v4u __attribute__((ext_vector_type(4)));
typedef unsigned v2u __attribute__((ext_vector_type(2)));
typedef float f32x4 __attribute__((ext_vector_type(4)));
typedef GAS unsigned gu32;
#define RLX_AGENT __ATOMIC_RELAXED, __HIP_MEMORY_SCOPE_AGENT
#define LDS_WAIT() asm volatile("s_waitcnt lgkmcnt(0)" ::: "memory")
#define VM_WAIT() asm volatile("s_waitcnt vmcnt(0)" ::: "memory")
__device__ __forceinline__ unsigned f2bf(float f) { unsigned u = __builtin_bit_cast(unsigned, f); return (u + 0x7fffu + ((u >> 16) & 1u)) >> 16; }
__device__ __forceinline__ unsigned pk2(float lo, float hi) { return f2bf(lo) | (f2bf(hi) << 16); }
__device__ __forceinline__ float bflo(unsigned w) { return __builtin_bit_cast(float, w << 16); }
__device__ __forceinline__ float bfhi(unsigned w) { return __builtin_bit_cast(float, w & 0xffff0000u); }
__device__ __forceinline__ float bf1(bf16 h) { return __builtin_bit_cast(float, (unsigned)h << 16); }
__device__ __forceinline__ float sigm(float x) { return 1.0f / (1.0f + __expf(-x)); }
__device__ __forceinline__ float wave_sum(float v) {
#pragma unroll
    for (int o = 1; o < 64; o <<= 1) v += __shfl_xor(v, o);
    return v;
}
template <int CTRL> __device__ __forceinline__ float dpp_mov(float v) { return __builtin_bit_cast(float, __builtin_amdgcn_update_dpp(0, __builtin_bit_cast(int, v), CTRL, 0xf, 0xf, false)); }
__device__ __forceinline__ float rowsum16(float v) {
    v += dpp_mov<0xB1>(v); v += dpp_mov<0x4E>(v); v += dpp_mov<0x124>(v); v += dpp_mov<0x128>(v); return v;
}

#define XB_TMO      128
#define XB_XCNT(j)  (256  + 64 * (j))
#define XB_XSUB(j)  (1280 + 64 * (j))
#define XB_XGEN(j)  (2304 + 64 * (j))
#define XB_TOP      3328
#define XB_TOPGEN   3392
#define XCD_BAR_WORDS 3456
#define XB_SPIN_CAP (1u << 18)

__device__ __forceinline__ unsigned xb_ld(unsigned* p)              { return __hip_atomic_load(p, __ATOMIC_RELAXED, __HIP_MEMORY_SCOPE_AGENT); }
__device__ __forceinline__ unsigned xb_add(unsigned* p, unsigned v) { return __hip_atomic_fetch_add(p, v, __ATOMIC_RELAXED, __HIP_MEMORY_SCOPE_AGENT); }
__device__ __forceinline__ unsigned xb_xcc_id() { return (unsigned)__builtin_amdgcn_s_getreg((3 << 11) | 20) & 0xFu; }
#define XB_SPIN(cond, bar) do { unsigned _sp = 0; while (cond) { __builtin_amdgcn_s_sleep(1); \
    if ((++_sp & 255u) == 0u) { if (xb_ld(&(bar)[XB_TMO])) break; if (_sp > XB_SPIN_CAP) { atomicAdd(&(bar)[XB_TMO], 1u); break; } } } } while (0)

struct XcdBarrier {
    unsigned* bar; unsigned x;
    volatile LAS unsigned* st;
};

__device__ __forceinline__ XcdBarrier xcd_barrier_post(unsigned* bar, volatile LAS unsigned* st) {
    XcdBarrier b; b.bar = bar; b.x = xb_xcc_id(); b.st = st;
    if (threadIdx.x == 0) (void)xb_add(&bar[XB_XCNT(b.x)], 1u);
    return b;
}
__device__ __forceinline__ void xcd_barrier_complete(unsigned* bar, unsigned x, unsigned& nloc, unsigned& nx) {
    const unsigned G = gridDim.x * gridDim.y * gridDim.z;
    unsigned sum, cnt, mine, sp = 0u;
    for (;;) {
        sum = 0u; cnt = 0u; mine = 0u;
#pragma unroll
        for (unsigned j = 0; j < 16; ++j) { const unsigned c = xb_ld(&bar[XB_XCNT(j)]); sum += c; cnt += (c > 0u) ? 1u : 0u; mine = (j == x) ? c : mine; }
        if (sum == G) break;
        __builtin_amdgcn_s_sleep(1);
        if ((++sp & 255u) == 0u) { if (xb_ld(&bar[XB_TMO])) break; if (sp > XB_SPIN_CAP) { atomicAdd(&bar[XB_TMO], 1u); break; } }
    }
    nloc = mine > 0u ? mine : 1u; nx = cnt > 0u ? cnt : 1u;
}

__device__ __forceinline__ void xcd_barrier(const XcdBarrier& b) {
    asm volatile("s_waitcnt vmcnt(0)" ::: "memory");
    __syncthreads();
    if (threadIdx.x == 0) {
        unsigned* bar = b.bar;
        __builtin_amdgcn_s_waitcnt(0);
        unsigned nloc = b.st[0], nx = b.st[1];
        if (nloc == 0u) { xcd_barrier_complete(bar, b.x, nloc, nx); b.st[0] = nloc; b.st[1] = nx; }
        const unsigned old = xb_add(&bar[XB_XSUB(b.x)], 1u);
        const unsigned gen = old / nloc;
        if (old + 1u == (gen + 1u) * nloc) {
            __builtin_amdgcn_fence(__ATOMIC_RELEASE, "agent");
            asm volatile("s_waitcnt vmcnt(0)" ::: "memory");
            const unsigned og = xb_add(&bar[XB_TOP], 1u);
            const unsigned tg = og / nx;
            if (og + 1u == (tg + 1u) * nx) xb_add(&bar[XB_TOPGEN], 1u);
            else XB_SPIN(xb_ld(&bar[XB_TOPGEN]) == tg, bar);
            __builtin_amdgcn_fence(__ATOMIC_ACQUIRE, "agent");
            xb_add(&bar[XB_XGEN(b.x)], 1u);
            asm volatile("s_waitcnt vmcnt(0)" ::: "memory");
        } else {
            XB_SPIN(xb_ld(&bar[XB_XGEN(b.x)]) == gen, bar);
            __builtin_amdgcn_fence(__ATOMIC_ACQUIRE, "agent");
            asm volatile("s_waitcnt vmcnt(0)" ::: "memory");
        }
    }
    __syncthreads();
}

struct Args { const float* in[33]; float* out; unsigned char* ws; int ph_lo, ph_hi; };
struct Frame {
    LAS unsigned char* lds; unsigned char* ws; float* H;
    int tid, lane, wave, G, bid;
};
template <class Tp> __device__ __forceinline__ Tp* wsp(const Frame& F, size_t off) { return (Tp*)(F.ws + off); }
__device__ __forceinline__ const float* kin(int i) { return ((const float* const __attribute__((address_space(4)))*)__builtin_amdgcn_kernarg_segment_ptr())[i]; }

__device__ __forceinline__ void tr_item(const float* W, int ldw, int k0, int nsrc0, bf16* WT, int kp, int rdst0, LAS float* scr, int lane, const float* kgain = nullptr) {
#pragma unroll
    for (int i = 0; i < 8; ++i) { const int kk = 8 * i + (lane >> 3), n4 = (lane & 7) * 4; const f32x4 x = __builtin_nontemporal_load((const f32x4*)(W + (size_t)(k0 + kk) * ldw + nsrc0 + n4));
        const float g = kgain ? kgain[k0 + kk] : 1.0f; LAS float* d = scr + kk * 33 + n4; d[0] = x.x * g; d[1] = x.y * g; d[2] = x.z * g; d[3] = x.w * g; }
    LDS_WAIT(); asm volatile("" ::: "memory");
    const int c = lane & 7;
#pragma unroll
    for (int j = 0; j < 4; ++j) { const int n = (lane >> 3) + 8 * j; const LAS float* s = scr + (8 * c) * 33 + n;
        v4u o; o.x = pk2(s[0 * 33], s[1 * 33]); o.y = pk2(s[2 * 33], s[3 * 33]); o.z = pk2(s[4 * 33], s[5 * 33]); o.w = pk2(s[6 * 33], s[7 * 33]);
        *(v4u*)(WT + (size_t)(rdst0 + n) * kp + k0 + 8 * c) = o; }
    LDS_WAIT(); asm volatile("" ::: "memory");
}
template <int MODE> __device__ __forceinline__ void tr_matrix(const Frame& F, int& itbase, const float* W, int ldw, int K, int nsrc0, int nblk, bf16* WT, int kp, int rdst0, LAS float* scr, const float* kgain = nullptr) {
    const int gw = F.bid * NWAVES + F.wave, NGW = F.G * NWAVES; const int nit = (K / 64) * nblk;
    int first = (gw - itbase % NGW + NGW) % NGW;
    for (int it = first; it < nit; it += NGW) { const int kb = it / nblk, nb = it % nblk, n = 32 * nb;
        const int rd = MODE == 0 ? rdst0 + n : 256 * (n >> 7) + (n & 127) + rdst0;
        tr_item(W, ldw, 64 * kb, nsrc0 + n, WT, kp, rd, scr, F.lane, kgain); }
    itbase += nit;
}
__device__ __forceinline__ void tr_item8(const float* W, int ldw, int k0, int nsrc0, unsigned char* WT, int kp, int rdst0, LAS float* scr, int lane, float sc) {
#pragma unroll
    for (int i = 0; i < 8; ++i) { const int kk = 8 * i + (lane >> 3), n4 = (lane & 7) * 4; const f32x4 x = __builtin_nontemporal_load((const f32x4*)(W + (size_t)(k0 + kk) * ldw + nsrc0 + n4));
        LAS float* d = scr + kk * 33 + n4; d[0] = x.x * sc; d[1] = x.y * sc; d[2] = x.z * sc; d[3] = x.w * sc; }
    LDS_WAIT(); asm volatile("" ::: "memory");
    const int c = lane & 3;
#pragma unroll
    for (int j = 0; j < 2; ++j) { const int n = (lane >> 2) + 16 * j; const LAS float* s = scr + (16 * c) * 33 + n;
        v4u o; o.x = pg8::pk4_fp8(s[0 * 33], s[1 * 33], s[2 * 33], s[3 * 33]); o.y = pg8::pk4_fp8(s[4 * 33], s[5 * 33], s[6 * 33], s[7 * 33]);
        o.z = pg8::pk4_fp8(s[8 * 33], s[9 * 33], s[10 * 33], s[11 * 33]); o.w = pg8::pk4_fp8(s[12 * 33], s[13 * 33], s[14 * 33], s[15 * 33]);
        *(v4u*)(WT + (size_t)(rdst0 + n) * kp + k0 + 16 * c) = o; }
    LDS_WAIT(); asm volatile("" ::: "memory");
}
template <int MODE> __device__ __forceinline__ void tr_matrix8(const Frame& F, int& itbase, const float* W, int ldw, int K, int nsrc0, int nblk, unsigned char* WT, int kp, int rdst0, LAS float* scr, float sc) {
    const int gw = F.bid * NWAVES + F.wave, NGW = F.G * NWAVES; const int nit = (K / 64) * nblk;
    int first = (gw - itbase % NGW + NGW) % NGW;
    for (int it = first; it < nit; it += NGW) { const int kb = it / nblk, nb = it % nblk, n = 32 * nb;
        const int rd = MODE == 0 ? rdst0 + n : 256 * (n >> 7) + (n & 127) + rdst0;
        tr_item8(W, ldw, 64 * kb, nsrc0 + n, WT, kp, rd, scr, F.lane, sc); }
    itbase += nit;
}
__device__ __forceinline__ void rms_load(const Frame& F, const float* xrow, f32x4 (&v)[4]) {
    const f32x4* xr = (const f32x4*)xrow + F.lane;
#pragma unroll
    for (int j = 0; j < 4; ++j) v[j] = xr[64 * j];
}
__device__ __forceinline__ void rms_load(const Frame& F, const bf16* xrow, f32x4 (&v)[4]) {
    const v2u* xr = (const v2u*)xrow + F.lane;
#pragma unroll
    for (int j = 0; j < 4; ++j) { const v2u w = xr[64 * j]; v[j] = (f32x4){bflo(w.x), bfhi(w.x), bflo(w.y), bfhi(w.y)}; }
}
struct RmsRawF { f32x4 w[4]; }; struct RmsRawH { v2u w[4]; };
__device__ __forceinline__ void rms_rawload(const Frame& F, const float* xrow, RmsRawF& r) { const f32x4* xr = (const f32x4*)xrow + F.lane; _Pragma("unroll") for (int j = 0; j < 4; ++j) r.w[j] = xr[64 * j]; }
__device__ __forceinline__ void rms_rawload(const Frame& F, const bf16* xrow, RmsRawH& r) { const v2u* xr = (const v2u*)xrow + F.lane; _Pragma("unroll") for (int j = 0; j < 4; ++j) r.w[j] = xr[64 * j]; }
__device__ __forceinline__ void rms_unpack(const RmsRawF& r, f32x4 (&v)[4]) { _Pragma("unroll") for (int j = 0; j < 4; ++j) v[j] = r.w[j]; }
__device__ __forceinline__ void rms_unpack(const RmsRawH& r, f32x4 (&v)[4]) { _Pragma("unroll") for (int j = 0; j < 4; ++j) v[j] = (f32x4){bflo(r.w[j].x), bfhi(r.w[j].x), bflo(r.w[j].y), bfhi(r.w[j].y)}; }
template <class P> struct RmsRawT { typedef RmsRawF type; };
template <> struct RmsRawT<bf16*> { typedef RmsRawH type; };
template <> struct RmsRawT<const bf16*> { typedef RmsRawH type; };
__device__ __forceinline__ void rms_finish(const Frame& F, const f32x4 (&gq)[4], bf16* orow, f32x4 (&v)[4]) {
    float s = 0.f;
#pragma unroll
    for (int j = 0; j < 4; ++j) s += (v[j].x * v[j].x + v[j].y * v[j].y) + (v[j].z * v[j].z + v[j].w * v[j].w);
    const float rstd = 1.0f / sqrtf(wave_sum(s) * (1.f / D) + NORM_EPS);
    unsigned long long* o8 = (unsigned long long*)orow + F.lane;
#pragma unroll
    for (int j = 0; j < 4; ++j) { const f32x4 g = gq[j]; v[j] = v[j] * rstd * g;
        o8[64 * j] = (unsigned long long)pk2(v[j].x, v[j].y) | ((unsigned long long)pk2(v[j].z, v[j].w) << 32); }
}
__device__ __forceinline__ void rms_finish(const Frame& F, const f32x4 (&gq)[4], unsigned char* orow, f32x4 (&v)[4]) {
    float s = 0.f;
#pragma unroll
    for (int j = 0; j < 4; ++j) s += (v[j].x * v[j].x + v[j].y * v[j].y) + (v[j].z * v[j].z + v[j].w * v[j].w);
    const float rstd = 1.0f / sqrtf(wave_sum(s) * (1.f / D) + NORM_EPS);
    unsigned* o4 = (unsigned*)orow + F.lane;
#pragma unroll
    for (int j = 0; j < 4; ++j) { const f32x4 g = gq[j]; v[j] = v[j] * rstd * g;
        o4[64 * j] = pg8::pk4_fp8(F8_SX * v[j].x, F8_SX * v[j].y, F8_SX * v[j].z, F8_SX * v[j].w); }
}
__device__ __forceinline__ void rms_row(const Frame& F, const float* xrow, const float* gain, bf16* orow, f32x4 (&v)[4]) { f32x4 gq[4]; for (int j = 0; j < 4; ++j) gq[j] = ((const f32x4*)gain)[F.lane + 64 * j]; rms_load(F, xrow, v); rms_finish(F, gq, orow, v); }
#define RMS_ROWS(src, gain, dst, BODY) do { typename RmsRawT<decltype(src)>::type ra_, rb_; f32x4 vv_[4], gq_[4]; _Pragma("unroll") for (int j_ = 0; j_ < 4; ++j_) gq_[j_] = ((const f32x4*)(gain))[F.lane + 64 * j_]; \
        int m = gw; \
        if (NGW * 16 == T) { typename RmsRawT<decltype(src)>::type rc_, rd_; \
            rms_rawload(F, (src) + (size_t)m * D, ra_); rms_rawload(F, (src) + (size_t)(m + NGW) * D, rb_); rms_rawload(F, (src) + (size_t)(m + 2 * NGW) * D, rc_); rms_rawload(F, (src) + (size_t)(m + 3 * NGW) * D, rd_); \
            _Pragma("unroll") for (int i_ = 0; i_ < 4; ++i_) { \
                rms_unpack(ra_, vv_); if (i_ < 3) rms_rawload(F, (src) + (size_t)(m + 4 * NGW) * D, ra_); rms_finish(F, gq_, (dst) + (size_t)m * D, vv_); { const int mm = m; f32x4 (&v)[4] = vv_; (void)v; BODY; } \
                rms_unpack(rb_, vv_); if (i_ < 3) rms_rawload(F, (src) + (size_t)(m + 5 * NGW) * D, rb_); rms_finish(F, gq_, (dst) + (size_t)(m + NGW) * D, vv_); { const int mm = m + NGW; f32x4 (&v)[4] = vv_; (void)v; BODY; } \
                rms_unpack(rc_, vv_); if (i_ < 3) rms_rawload(F, (src) + (size_t)(m + 6 * NGW) * D, rc_); rms_finish(F, gq_, (dst) + (size_t)(m + 2 * NGW) * D, vv_); { const int mm = m + 2 * NGW; f32x4 (&v)[4] = vv_; (void)v; BODY; } \
                rms_unpack(rd_, vv_); if (i_ < 3) rms_rawload(F, (src) + (size_t)(m + 7 * NGW) * D, rd_); rms_finish(F, gq_, (dst) + (size_t)(m + 3 * NGW) * D, vv_); { const int mm = m + 3 * NGW; f32x4 (&v)[4] = vv_; (void)v; BODY; } \
                m += 4 * NGW; } } \
        else { if (m < T) rms_rawload(F, (src) + (size_t)m * D, ra_); \
        for (; m < T; m += 2 * NGW) { if (m + NGW < T) rms_rawload(F, (src) + (size_t)(m + NGW) * D, rb_); \
            rms_unpack(ra_, vv_); rms_finish(F, gq_, (dst) + (size_t)m * D, vv_); { const int mm = m; f32x4 (&v)[4] = vv_; (void)v; BODY; } \
            if (m + NGW < T) { if (m + 2 * NGW < T) rms_rawload(F, (src) + (size_t)(m + 2 * NGW) * D, ra_); \
                rms_unpack(rb_, vv_); rms_finish(F, gq_, (dst) + (size_t)(m + NGW) * D, vv_); { const int mm = m + NGW; f32x4 (&v)[4] = vv_; (void)v; BODY; } } } } } while (0)
__device__ __forceinline__ void stage_w8(const Frame& F, const float* W, int ldw, int c0) {
    LAS float* WL = (LAS float*)(F.lds + 65536);
    for (int k = F.tid; k < D; k += NTHR) { const int lane = (k & 255) >> 2, j = k >> 8, q = k & 3; const float* wr = W + (size_t)k * ldw + c0;
#pragma unroll
        for (int e = 0; e < 8; ++e) WL[((j * 4 + q) * 64 + lane) * 8 + e] = wr[e]; }
    __syncthreads();
}
__device__ __forceinline__ void row_dot8(const Frame& F, const f32x4 (&v)[4], float (&o)[8]) {
    const LAS float* WL = (const LAS float*)(F.lds + 65536); const int lane = F.lane;
    float a[8];
#pragma unroll
    for (int e = 0; e < 8; ++e) a[e] = 0.f;
#pragma unroll
    for (int j = 0; j < 4; ++j)
#pragma unroll
        for (int q = 0; q < 4; ++q) { const float xv = v[j][q]; const LAS f32x4* wp = (const LAS f32x4*)(WL + ((j * 4 + q) * 64 + lane) * 8); const f32x4 w0 = wp[0], w1 = wp[1];
            a[0] += xv * w0.x; a[1] += xv * w0.y; a[2] += xv * w0.z; a[3] += xv * w0.w; a[4] += xv * w1.x; a[5] += xv * w1.y; a[6] += xv * w1.z; a[7] += xv * w1.w; }
    const bool b5 = lane & 32, b4 = lane & 16, b3 = lane & 8;
    float c4[4];
#pragma unroll
    for (int i = 0; i < 4; ++i) { const float keep = b5 ? a[4 + i] : a[i], send = b5 ? a[i] : a[4 + i]; c4[i] = keep + __shfl_xor(send, 32); }
    float c2[2];
#pragma unroll
    for (int i = 0; i < 2; ++i) { const float keep = b4 ? c4[2 + i] : c4[i], send = b4 ? c4[i] : c4[2 + i]; c2[i] = keep + __shfl_xor(send, 16); }
    float c1; { const float keep = b3 ? c2[1] : c2[0], send = b3 ? c2[0] : c2[1]; c1 = keep + __shfl_xor(send, 8); }
    c1 += __shfl_xor(c1, 4); c1 += __shfl_xor(c1, 2); c1 += __shfl_xor(c1, 1);
#pragma unroll
    for (int e = 0; e < 8; ++e) o[e] = __builtin_bit_cast(float, __builtin_amdgcn_readlane(__builtin_bit_cast(int, c1), 8 * e));
}

__device__ __forceinline__ void p0_prologue(const Frame& F, const Args& a) {
    LAS float* scr = (LAS float*)(F.lds + F.wave * 16384);
    const int gw = F.bid * NWAVES + F.wave, NGW = F.G * NWAVES, gt = F.bid * NTHR + F.tid, NGT = F.G * NTHR;
    int itb = 0;
    tr_matrix<0>(F, itb, kin(2), IN0, D, 0, IN0 / 32, wsp<bf16>(F, WS_WIN0), D, 0, scr);
    tr_matrix<0>(F, itb, kin(15), 768, QR, 0, 768 / 32, wsp<bf16>(F, WS_WUQ), QR, 0, scr);
    tr_matrix<0>(F, itb, kin(17), 1024, KVR, 0, 1024 / 32, wsp<bf16>(F, WS_WUKV), KVR, 0, scr);
    tr_matrix<0>(F, itb, kin(18), D, D, 0, D / 32, wsp<bf16>(F, WS_WOUT0), D, 0, scr);
    tr_matrix<1>(F, itb, kin(20), DFF, D, 0, DFF / 32, wsp<bf16>(F, WS_WGU0), D, 0, scr);
    tr_matrix<1>(F, itb, kin(21), DFF, D, 0, DFF / 32, wsp<bf16>(F, WS_WGU0), D, 128, scr);
    tr_matrix<0>(F, itb, kin(22), D, DFF, 0, D / 32, wsp<bf16>(F, WS_WD0), DFF, 0, scr);
    tr_matrix<0>(F, itb, kin(24), IN1, D, 0, 1536 / 32, wsp<bf16>(F, WS_WIN1), D, 0, scr);
    tr_matrix<0>(F, itb, kin(24), IN1, D, 1544, 1536 / 32, wsp<bf16>(F, WS_WIN1), D, 1536, scr);
    tr_matrix<0>(F, itb, kin(26), D, D, 0, D / 32, wsp<bf16>(F, WS_WOUT1), D, 0, scr);
    { unsigned* z = (unsigned*)(wsp<bf16>(F, WS_WIN0) + (size_t)IN0 * D); for (int i = gt; i < (IN0P - IN0) * D / 2; i += NGT) z[i] = 0u; }
    { bf16* L = wsp<bf16>(F, WS_WLORA); const float* w2 = kin(5); const float* a2 = kin(7); const float* g2 = kin(8);
      for (int i = gt; i < 1536 * 256; i += NGT) { const int n = i >> 8, k = i & 255; float v = 0.f;
          if (n < 512) { if (k < 64) v = w2[k * 512 + n]; } else if (n < 1024) { if (k >= 64 && k < 128) v = a2[(k - 64) * 512 + (n - 512)]; } else { if (k >= 128) v = g2[(k - 128) * 512 + (n - 1024)]; }
          L[i] = (bf16)f2bf(v); } }
    { float* r32 = wsp<float>(F, WS_ROPE32); float* r64 = wsp<float>(F, WS_ROPE64);
      for (int i = gt; i < S * 16; i += NGT) { const int pos = i >> 4, j = i & 15; const float inv = powf(10000.0f, -(float)(2 * j) / 32.0f); const float ang = (float)pos * inv; r32[2 * i] = cosf(ang); r32[2 * i + 1] = sinf(ang); }
      for (int i = gt; i < S * 32; i += NGT) { const int pos = i >> 5, j = i & 31; const float inv = powf(10000.0f, -(float)(2 * j) / 64.0f); const float ang = (float)pos * inv; r64[2 * i] = cosf(ang); r64[2 * i + 1] = sinf(ang); } }
    RMS_ROWS(kin(0), kin(1), wsp<bf16>(F, WS_XN), (void)mm);
}

typedef float f32x2_t __attribute__((ext_vector_type(2)));
struct P2Raw { v4u rkv[3]; v2u lin, ql; unsigned kvl; bf16 x1, x2; float rc, rs; };
__device__ __forceinline__ void p2_load(P2Raw& q, const bf16* cur, const float* r32, int pos, int lane) {
#pragma unroll
    for (int c = 0; c < 3; ++c) q.rkv[c] = *(const v4u*)(cur + c * 512 + lane * 8);
    q.lin = *(const v2u*)(cur + C_WD + 4 * lane); q.ql = *(const v2u*)(cur + C_QL + 4 * lane); q.kvl = *(const unsigned*)(cur + C_KVL + 2 * lane);
    q.x1 = cur[C_KR + (lane & 15)]; q.x2 = cur[C_KR + 16 + (lane & 15)]; const f32x2_t cs = *(const f32x2_t*)(r32 + (pos * 16 + (lane & 15)) * 2); q.rc = cs[0]; q.rs = cs[1];
}
__device__ __forceinline__ void p2_prep0(const Frame& F, const Args& a) {
    const int gw = F.bid * NWAVES + F.wave, NGW = F.G * NWAVES, lane = F.lane;
    const bf16* P = wsp<bf16>(F, WS_PROJ0); const float* mu = kin(3);
    bf16* RKV = wsp<bf16>(F, WS_RKV); bf16* LIN = wsp<bf16>(F, WS_LIN); bf16* QN = wsp<bf16>(F, WS_QN); bf16* KVN = wsp<bf16>(F, WS_KVN); bf16* KPE = wsp<bf16>(F, WS_KPE);
    const float* r32 = wsp<float>(F, WS_ROPE32);
    const int run = (T + NGW - 1) / NGW, t0 = gw * run, t1 = t0 + run < T ? t0 + run : T;
    if (t0 >= t1) return;
    float mrkv[3][8], mlin[4], gq[4], gkv[2];
#pragma unroll
    for (int c = 0; c < 3; ++c) { const f32x4 m0 = *(const f32x4*)(mu + c * 512 + lane * 8), m1 = *(const f32x4*)(mu + c * 512 + lane * 8 + 4);
#pragma unroll
        for (int e = 0; e < 4; ++e) { mrkv[c][e] = m0[e]; mrkv[c][4 + e] = m1[e]; } }
    { const f32x4 m = *(const f32x4*)(mu + C_WD + 4 * lane), g = *(const f32x4*)(kin(14) + 4 * lane); const f32x2_t k = *(const f32x2_t*)(kin(16) + 2 * lane);
#pragma unroll
      for (int e = 0; e < 4; ++e) { mlin[e] = m[e]; gq[e] = g[e]; }
      gkv[0] = k[0]; gkv[1] = k[1]; }
    const float fA = lane < 16 ? 2.0f : (lane < 32 ? 0.0f : 1.0f), fB = lane < 16 ? -2.0f * 1.44269504f : (lane < 32 ? 0.0f : -1.44269504f), fC = (lane >= 16 && lane < 32) ? 1.0f : 0.0f, fD = lane < 16 ? -1.0f : 0.0f;
    P2Raw cur, nxt; v4u prkv[3]; v2u plin;
    p2_load(cur, P + (size_t)t0 * IN0P, r32, t0 % S, lane);
    if (t0 % S) { const bf16* pv = P + (size_t)(t0 - 1) * IN0P;
#pragma unroll
        for (int c = 0; c < 3; ++c) prkv[c] = *(const v4u*)(pv + c * 512 + lane * 8);
        plin = *(const v2u*)(pv + C_WD + 4 * lane); }
    else { prkv[0] = prkv[1] = prkv[2] = (v4u){0u, 0u, 0u, 0u}; plin = (v2u){0u, 0u}; }
    for (int t = t0; t < t1; ++t) {
        if (t + 1 < t1) p2_load(nxt, P + (size_t)(t + 1) * IN0P, r32, (t + 1) % S, lane);
        if (t != t0 && (t % S) == 0) { prkv[0] = prkv[1] = prkv[2] = (v4u){0u, 0u, 0u, 0u}; plin = (v2u){0u, 0u}; }
#pragma unroll
        for (int c = 0; c < 3; ++c) { v4u o;
#pragma unroll
            for (int e = 0; e < 4; ++e) { const float c0 = bflo(cur.rkv[c][e]), c1 = bfhi(cur.rkv[c][e]), p0 = bflo(prkv[c][e]), p1 = bfhi(prkv[c][e]);
                o[e] = pk2(c0 + mrkv[c][2 * e] * (p0 - c0), c1 + mrkv[c][2 * e + 1] * (p1 - c1)); }
            *(v4u*)(RKV + (size_t)t * 1536 + c * 512 + lane * 8) = o; }
        { float y[4];
#pragma unroll
          for (int e = 0; e < 2; ++e) { const float c0 = bflo(cur.lin[e]), c1 = bfhi(cur.lin[e]), p0 = bflo(plin[e]), p1 = bfhi(plin[e]);
              const float x0 = c0 + mlin[2 * e] * (p0 - c0), x1 = c1 + mlin[2 * e + 1] * (p1 - c1);
              y[2 * e] = fA * __builtin_amdgcn_rcpf(1.0f + __builtin_amdgcn_exp2f(fB * x0)) + fC * x0 + fD; y[2 * e + 1] = fA * __builtin_amdgcn_rcpf(1.0f + __builtin_amdgcn_exp2f(fB * x1)) + fC * x1 + fD; }
          v2u o; o[0] = pk2(y[0], y[1]); o[1] = pk2(y[2], y[3]); *(v2u*)(LIN + (size_t)t * 256 + 4 * lane) = o; }
        { const float q0 = bflo(cur.ql[0]), q1 = bfhi(cur.ql[0]), q2 = bflo(cur.ql[1]), q3 = bfhi(cur.ql[1]), k0 = bflo(cur.kvl), k1 = bfhi(cur.kvl);
          float sq = (q0 * q0 + q1 * q1) + (q2 * q2 + q3 * q3), sk = k0 * k0 + k1 * k1;
#pragma unroll
          for (int o = 1; o < 64; o <<= 1) { sq += __shfl_xor(sq, o); sk += __shfl_xor(sk, o); }
          const float rq = 1.0f / sqrtf(sq * (1.f / QR) + NORM_EPS), rk = 1.0f / sqrtf(sk * (1.f / KVR) + NORM_EPS);
          v2u o; o[0] = pk2(q0 * rq * gq[0], q1 * rq * gq[1]); o[1] = pk2(q2 * rq * gq[2], q3 * rq * gq[3]); *(v2u*)(QN + (size_t)t * QR + 4 * lane) = o;
          *(unsigned*)(KVN + (size_t)t * KVR + 2 * lane) = pk2(k0 * rk * gkv[0], k1 * rk * gkv[1]); }
        if (lane < 16) { const float x1 = bf1(cur.x1), x2 = bf1(cur.x2); KPE[(size_t)t * 32 + lane] = (bf16)f2bf(x1 * cur.rc - x2 * cur.rs); KPE[(size_t)t * 32 + 16 + lane] = (bf16)f2bf(x2 * cur.rc + x1 * cur.rs); }
#pragma unroll
        for (int c = 0; c < 3; ++c) prkv[c] = cur.rkv[c];
        plin = cur.lin; cur = nxt;
    }
}

constexpr int SC_CH = 32, SC_V = SC_CH * 16 * 80, SC_BUF = SC_V + SC_CH * 16 * 4;
typedef float f32x2 __attribute__((ext_vector_type(2)));
struct ScOp { f32x4 a, w, k, b, r; float v; };
__device__ __forceinline__ void rowsum16x2(float& x, float& y) {
    asm volatile("s_nop 1\n\t"
                 "v_add_f32_dpp %0, %0, %0 quad_perm:[1,0,3,2] row_mask:0xf bank_mask:0xf bound_ctrl:1\n\t"
                 "v_add_f32_dpp %1, %1, %1 quad_perm:[1,0,3,2] row_mask:0xf bank_mask:0xf bound_ctrl:1\n\t"
                 "s_nop 0\n\t"
                 "v_add_f32_dpp %0, %0, %0 quad_perm:[2,3,0,1] row_mask:0xf bank_mask:0xf bound_ctrl:1\n\t"
                 "v_add_f32_dpp %1, %1, %1 quad_perm:[2,3,0,1] row_mask:0xf bank_mask:0xf bound_ctrl:1\n\t"
                 "s_nop 0\n\t"
                 "v_add_f32_dpp %0, %0, %0 row_ror:4 row_mask:0xf bank_mask:0xf bound_ctrl:1\n\t"
                 "v_add_f32_dpp %1, %1, %1 row_ror:4 row_mask:0xf bank_mask:0xf bound_ctrl:1\n\t"
                 "s_nop 0\n\t"
                 "v_add_f32_dpp %0, %0, %0 row_ror:8 row_mask:0xf bank_mask:0xf bound_ctrl:1\n\t"
                 "v_add_f32_dpp %1, %1, %1 row_ror:8 row_mask:0xf bank_mask:0xf bound_ctrl:1\n\t"
                 "s_nop 1" : "+v"(x), "+v"(y));
}
__device__ __forceinline__ float sum8(float v) { v += dpp_mov<0xB1>(v); v += dpp_mov<0x4E>(v); v += dpp_mov<0x141>(v); return v; }
constexpr int SCAN_ITEMS = NB * NH * 4;
__device__ __forceinline__ void rwkv_scan_item(const Frame& F, const Args& a_, int item) {
    const int b = item >> 5, h = (item >> 2) & 7, qtr = item & 3; const int tid = F.tid, lane = tid & 63, wave = __builtin_amdgcn_readfirstlane(tid >> 6);
    LAS unsigned char* L = F.lds;
    constexpr int NCH = S / SC_CH;
    __syncthreads();
    if (wave >= 4) {
        const bf16* RKV = wsp<bf16>(F, WS_RKV); const bf16* EW = wsp<bf16>(F, WS_EW); const bf16* AA = wsp<bf16>(F, WS_AA);
        const int pt = tid - 256, ps = pt >> 3, pc = (pt & 7) * 8; const int ch = h * 64 + pc;
        float kkw[8], kaw[8];
#pragma unroll
        for (int e = 0; e < 8; ++e) { kkw[e] = kin(9)[ch + e]; kaw[e] = kin(10)[ch + e]; }
        for (int c = 0; c <= NCH; ++c) {
            if (c < NCH) { const size_t tok = (size_t)b * S + c * SC_CH + ps; const int bo = (c & 1) * SC_BUF;
                const v4u rw = *(const v4u*)(RKV + tok * 1536 + C_R + ch), kw = *(const v4u*)(RKV + tok * 1536 + C_K + ch), vw = *(const v4u*)(RKV + tok * 1536 + C_V + ch);
                const v4u ew = *(const v4u*)(EW + tok * 512 + ch), aw = *(const v4u*)(AA + tok * 512 + ch);
                float r[8], k[8], v[8], w[8], al[8], kk[8]; float ss = 0.f;
#pragma unroll
                for (int e = 0; e < 4; ++e) { r[2 * e] = bflo(rw[e]); r[2 * e + 1] = bfhi(rw[e]); k[2 * e] = bflo(kw[e]); k[2 * e + 1] = bfhi(kw[e]); v[2 * e] = bflo(vw[e]); v[2 * e + 1] = bfhi(vw[e]);
                    w[2 * e] = bflo(ew[e]); w[2 * e + 1] = bfhi(ew[e]); al[2 * e] = bflo(aw[e]); al[2 * e + 1] = bfhi(aw[e]); }
#pragma unroll
                for (int e = 0; e < 8; ++e) { kk[e] = k[e] * kkw[e]; ss += kk[e] * kk[e]; }
                ss = sum8(ss); const float inv = 1.0f / fmaxf(sqrtf(ss), 1e-12f);
#pragma unroll
                for (int q = 0; q < 2; ++q) { f32x4 oa, ow, ok, ob, orr;
#pragma unroll
                    for (int e = 0; e < 4; ++e) { const int i = 4 * q + e; const float kn = kk[i] * inv; oa[e] = -kn; ow[e] = __expf(-w[i]); ok[e] = k[i] * (1.0f + (al[i] - 1.0f) * kaw[i]); ob[e] = kn * al[i]; orr[e] = r[i]; }
                    LAS f32x4* dst = (LAS f32x4*)(L + bo + (ps * 16 + (pt & 7) * 2 + q) * 80); dst[0] = oa; dst[1] = ow; dst[2] = ok; dst[3] = ob; dst[4] = orr; }
                if ((pc >> 4) == qtr) { LAS f32x4* vd = (LAS f32x4*)(L + bo + SC_V + ps * 64 + (pc & 15) * 4); vd[0] = (f32x4){v[0], v[1], v[2], v[3]}; vd[1] = (f32x4){v[4], v[5], v[6], v[7]}; } }
            __syncthreads();
        }
    } else {
        float* YR = wsp<float>(F, WS_YRAW);
        const int l15 = lane & 15, row0 = 4 * wave + (lane >> 4);
        f32x2 Sa = {0.f, 0.f}, Sb = Sa; float yk = 0.f, yp = 0.f;
        float* yout = YR + ((size_t)b * S + l15) * 512 + h * 64 + 16 * qtr + row0;
        __syncthreads();
        for (int c = 0; c < NCH; ++c) {
            const int t0 = c * SC_CH; const int bo = (c & 1) * SC_BUF;
            const LAS unsigned char* opb = L + bo + l15 * 80; const LAS unsigned char* vb = L + bo + SC_V + row0 * 4;
            ScOp o[3];
#define SC_LD(dst, s) do { const LAS f32x4* q = (const LAS f32x4*)(opb + (s) * 1280); dst.a = q[0]; dst.w = q[1]; dst.k = q[2]; dst.b = q[3]; dst.r = q[4]; dst.v = *(const LAS float*)(vb + (s) * 64); } while (0)
            SC_LD(o[0], 0); SC_LD(o[1], 1);
#pragma unroll
            for (int s = 0; s < SC_CH; ++s) {
                if (s + 2 < SC_CH) SC_LD(o[(s + 2) % 3], s + 2);
                __builtin_amdgcn_sched_barrier(0);
                const ScOp& c_ = o[s % 3];
                const f32x2 wa = {c_.w.x, c_.w.y}, wb = {c_.w.z, c_.w.w}, ka = {c_.k.x, c_.k.y}, kb = {c_.k.z, c_.k.w}, aa = {c_.a.x, c_.a.y}, ab = {c_.a.z, c_.a.w};
                const f32x2 ba = {c_.b.x, c_.b.y}, bb = {c_.b.z, c_.b.w}, ra = {c_.r.x, c_.r.y}, rb = {c_.r.z, c_.r.w};
                const f32x2 ta = Sa * wa + ka * c_.v, tb = Sb * wb + kb * c_.v;
                const f32x2 up = Sa * aa + Sb * ab; float u = up.x + up.y;
                rowsum16x2(u, yp);
                if (s > 0 || c > 0) { if (l15 == ((s + 15) & 15)) yk = yp; if (((s + 15) & 15) == 15) yout[(size_t)(t0 + s - 16) * 512] = yk; }
                Sa = ba * u + ta; Sb = bb * u + tb;
                const f32x2 yq = Sa * ra + Sb * rb; yp = yq.x + yq.y;
                __builtin_amdgcn_sched_barrier(0);
            }
#undef SC_LD
            __syncthreads();
        }
        { float dummy = 0.f; rowsum16x2(dummy, yp); if (l15 == 15) yk = yp; yout[(size_t)(S - 16) * 512] = yk; }
    }
}

__device__ __forceinline__ void p5_rwkv_post(const Frame& F, const Args& a) {
    const int gw = F.bid * NWAVES + F.wave, NGW = F.G * NWAVES, lane = F.lane, ch = lane * 8;
    const bf16* RKV = wsp<bf16>(F, WS_RKV); const bf16* AA = wsp<bf16>(F, WS_AA); const bf16* GG = wsp<bf16>(F, WS_GG); const float* YR = wsp<float>(F, WS_YRAW); bf16* YM = wsp<bf16>(F, WS_YMIX);
    float ka[8], rk[8], lg[8], lb[8];
#pragma unroll
    for (int e = 0; e < 8; ++e) { ka[e] = kin(10)[ch + e]; rk[e] = kin(11)[ch + e]; lg[e] = kin(12)[ch + e]; lb[e] = kin(13)[ch + e]; }
    for (int t = gw; t < T; t += NGW) {
        const v4u rw = *(const v4u*)(RKV + (size_t)t * 1536 + C_R + ch), kw = *(const v4u*)(RKV + (size_t)t * 1536 + C_K + ch), vw = *(const v4u*)(RKV + (size_t)t * 1536 + C_V + ch);
        const v4u aw = *(const v4u*)(AA + (size_t)t * 512 + ch), gw4 = *(const v4u*)(GG + (size_t)t * 512 + ch);
        const f32x4 y0 = *(const f32x4*)(YR + (size_t)t * 512 + ch), y1 = *(const f32x4*)(YR + (size_t)t * 512 + ch + 4);
        float y[8] = {y0.x, y0.y, y0.z, y0.w, y1.x, y1.y, y1.z, y1.w}; float r[8], k[8], v[8], al[8], g[8];
#pragma unroll
        for (int e = 0; e < 4; ++e) { r[2 * e] = bflo(rw[e]); r[2 * e + 1] = bfhi(rw[e]); k[2 * e] = bflo(kw[e]); k[2 * e + 1] = bfhi(kw[e]); v[2 * e] = bflo(vw[e]); v[2 * e + 1] = bfhi(vw[e]);
            al[2 * e] = bflo(aw[e]); al[2 * e + 1] = bfhi(aw[e]); g[2 * e] = bflo(gw4[e]); g[2 * e + 1] = bfhi(gw4[e]); }
        float s = 0.f, bs = 0.f;
#pragma unroll
        for (int e = 0; e < 8; ++e) { s += y[e]; const float kp = k[e] * (1.0f + (al[e] - 1.0f) * ka[e]); bs += r[e] * kp * rk[e]; }
        s += __shfl_xor(s, 1); s += __shfl_xor(s, 2); s += __shfl_xor(s, 4); bs += __shfl_xor(bs, 1); bs += __shfl_xor(bs, 2); bs += __shfl_xor(bs, 4);
        const float mean = s * (1.f / 64.f); float q = 0.f;
#pragma unroll
        for (int e = 0; e < 8; ++e) { const float d = y[e] - mean; q += d * d; }
        q += __shfl_xor(q, 1); q += __shfl_xor(q, 2); q += __shfl_xor(q, 4);
        const float rstd = 1.0f / sqrtf(q * (1.f / 64.f) + GN_EPS); v4u o;
#pragma unroll
        for (int e = 0; e < 4; ++e) { const float o0 = ((y[2 * e] - mean) * rstd * lg[2 * e] + lb[2 * e] + bs * v[2 * e]) * g[2 * e], o1 = ((y[2 * e + 1] - mean) * rstd * lg[2 * e + 1] + lb[2 * e + 1] + bs * v[2 * e + 1]) * g[2 * e + 1]; o[e] = pk2(o0, o1); }
        *(v4u*)(YM + (size_t)t * 1024 + ch) = o;
    }
}

constexpr int AT_K = 0, AT_V = 24576, AT_D = 40960;
template <int TYPE> __device__ __forceinline__ void attn_naive_unit(const Frame& F, int b, int h, int qc) {
    constexpr int DK = TYPE == 0 ? 96 : 64, DH = DK / 2; constexpr float LOG2E = 1.4426950408889634f;
    const float scale = (TYPE == 0 ? 0.10206207261596577f : 0.125f) * LOG2E;
    const int tid = F.tid, half = tid & 1; const int qpos = qc * 256 + (tid >> 1); const size_t tq = (size_t)b * S + qpos;
    LAS float* Ks = (LAS float*)(F.lds + AT_K); LAS float* Vs = (LAS float*)(F.lds + AT_V); LAS float* Ds = (LAS float*)(F.lds + AT_D);
    const bf16* Qp; const bf16* Kp; const bf16* Vp; int kpitch, vpitch;
    if (TYPE == 0) { Qp = wsp<bf16>(F, WS_QM) + tq * 768 + h * 96; Kp = wsp<bf16>(F, WS_KVM) + h * 128; Vp = Kp + 64; kpitch = 1024; vpitch = 1024; }
    else if (TYPE == 1) { Qp = wsp<bf16>(F, WS_PROJ1) + tq * IN1P + h * 64; Kp = wsp<bf16>(F, WS_PROJ1) + 512 + h * 64; Vp = wsp<bf16>(F, WS_PROJ1) + 1024 + h * 64; kpitch = IN1P; vpitch = IN1P; }
    else { Qp = wsp<bf16>(F, WS_PROJ1) + tq * IN1P + 1536 + h * 64; Kp = wsp<bf16>(F, WS_PROJ1) + 2048 + h * 64; Vp = wsp<bf16>(F, WS_PROJ1) + 2560 + h * 64; kpitch = IN1P; vpitch = IN1P; }
    float q[DH];
#pragma unroll
    for (int c = 0; c < DH / 8; ++c) { const v4u w = *(const v4u*)(Qp + half * DH + 8 * c);
#pragma unroll
        for (int e = 0; e < 4; ++e) { q[8 * c + 2 * e] = bflo(w[e]); q[8 * c + 2 * e + 1] = bfhi(w[e]); } }
    if (TYPE == 0) { const float* r32 = wsp<float>(F, WS_ROPE32) + (size_t)qpos * 32;
        if (half == 1) {
#pragma unroll
            for (int i = 0; i < 16; ++i) { const float c = r32[2 * i], s = r32[2 * i + 1], x1 = q[16 + i], x2 = q[32 + i]; q[16 + i] = x1 * c - x2 * s; q[32 + i] = x2 * c + x1 * s; } } }
#pragma unroll
    for (int d = 0; d < DH; ++d) q[d] *= scale;
    float dq = 0.f; unsigned mask = 0xffffffffu;
    if (TYPE == 1) dq = wsp<float>(F, WS_DCUM)[tq * 8 + h] * LOG2E;
    if (TYPE == 2) mask = wsp<unsigned>(F, WS_SEL)[tq * 8 + h];
    float o[32];
#pragma unroll
    for (int d = 0; d < 32; ++d) o[d] = 0.f;
    float m = -1e30f, l = 0.f;
    const int nt = (qc * 256 + 256) / 64;
    const int sr = tid >> 3, sc = (tid & 7) * 8;
    for (int tile = 0; tile < nt; ++tile) {
        __syncthreads();
        { const size_t tk = (size_t)b * S + tile * 64 + sr;
          const v4u kw = *(const v4u*)(Kp + tk * kpitch + sc), vw = *(const v4u*)(Vp + tk * vpitch + sc);
#pragma unroll
          for (int e = 0; e < 4; ++e) { Ks[sr * DK + sc + 2 * e] = bflo(kw[e]); Ks[sr * DK + sc + 2 * e + 1] = bfhi(kw[e]); Vs[sr * 64 + sc + 2 * e] = bflo(vw[e]); Vs[sr * 64 + sc + 2 * e + 1] = bfhi(vw[e]); }
          if (TYPE == 0) { const v2u pw = *(const v2u*)(wsp<bf16>(F, WS_KPE) + tk * 32 + (tid & 7) * 4);
#pragma unroll
              for (int e = 0; e < 2; ++e) { Ks[sr * DK + 64 + (tid & 7) * 4 + 2 * e] = bflo(pw[e]); Ks[sr * DK + 64 + (tid & 7) * 4 + 2 * e + 1] = bfhi(pw[e]); } }
          if (TYPE == 1 && tid < 64) Ds[tid] = wsp<float>(F, WS_DCUM)[((size_t)b * S + tile * 64 + tid) * 8 + h] * LOG2E; }
        __syncthreads();
        const int kbase = tile * 64;
        const bool need = (kbase <= qpos) && ((mask >> (tile >> 2)) & 1u);
        if (need) {
#pragma unroll 1
            for (int g = 0; g < 16; ++g) {
                float s[4];
#pragma unroll
                for (int j = 0; j < 4; ++j) { const int key = g * 4 + j; float a0 = 0.f, a1 = 0.f;
#pragma unroll
                    for (int d4 = 0; d4 < DH / 4; ++d4) { const f32x4 kv = *(const LAS f32x4*)(Ks + key * DK + half * DH + 4 * d4); a0 += q[4 * d4] * kv.x + q[4 * d4 + 1] * kv.y; a1 += q[4 * d4 + 2] * kv.z + q[4 * d4 + 3] * kv.w; }
                    float acc = a0 + a1; acc += dpp_mov<0xB1>(acc);
                    if (TYPE == 1) acc += dq - Ds[key];
                    s[j] = (kbase + key <= qpos) ? acc : -1e30f; }
                const float mx = fmaxf(fmaxf(s[0], s[1]), fmaxf(s[2], s[3]));
                const float mn = fmaxf(m, mx), corr = __builtin_amdgcn_exp2f(m - mn); m = mn; l *= corr;
#pragma unroll
                for (int d = 0; d < 32; ++d) o[d] *= corr;
#pragma unroll
                for (int j = 0; j < 4; ++j) { const float p = __builtin_amdgcn_exp2f(s[j] - mn); l += p; const int key = g * 4 + j;
#pragma unroll
                    for (int d4 = 0; d4 < 8; ++d4) { const f32x4 vv = *(const LAS f32x4*)(Vs + key * 64 + half * 32 + 4 * d4); o[4 * d4] += p * vv.x; o[4 * d4 + 1] += p * vv.y; o[4 * d4 + 2] += p * vv.z; o[4 * d4 + 3] += p * vv.w; } }
            }
        }
    }
    const float il = 1.0f / l; bf16* Op = wsp<bf16>(F, WS_YMIX) + tq * 1024 + (TYPE == 1 ? 0 : 512) + h * 64 + half * 32;
#pragma unroll
    for (int c = 0; c < 4; ++c) { v4u w;
#pragma unroll
        for (int e = 0; e < 4; ++e) w[e] = pk2(o[8 * c + 2 * e] * il, o[8 * c + 2 * e + 1] * il);
        *(v4u*)(Op + 8 * c) = w; }
}
template <int TYPE> __device__ __forceinline__ void attn_naive_phase(const Frame& F, int first, int nblk) {
    const int me = F.bid - first; if (me < 0 || me >= nblk) return;
    for (int i = me; i < NB * NH * 32; i += nblk) { const int qc = 31 - i / (NB * NH), bh = i % (NB * NH); attn_naive_unit<TYPE>(F, bh >> 3, bh & 7, qc); }
}

typedef short bf16x8_t __attribute__((ext_vector_type(8)));
typedef short s16x4_t __attribute__((ext_vector_type(4)));
typedef float f32x16_t __attribute__((ext_vector_type(16)));
__device__ __forceinline__ unsigned cvtpk(float lo, float hi) { unsigned r; asm volatile("v_cvt_pk_bf16_f32 %0, %1, %2" : "=v"(r) : "v"(lo), "v"(hi)); return r; }
__device__ __forceinline__ int crow(int r, int hi) { return (r & 3) + 8 * (r >> 2) + 4 * hi; }
template <int TYPE> __device__ __forceinline__ void attn_unit(const Frame& F, int b, int h, int qb) {
    constexpr int DK = TYPE == 0 ? 96 : 64, NC = DK / 16, KSTR = 144, PSTR = 80, VSTR = 192, KBUF = 64 * KSTR + (TYPE == 0 ? 64 * PSTR : 0), VBUF = 64 * VSTR;
    constexpr int NSL = 4, AK = 0, AV = NSL * KBUF, AD = NSL * KBUF + NSL * VBUF;
    constexpr float LOG2E = 1.4426950408889634f; const float scale = (TYPE == 0 ? 0.10206207261596577f : 0.125f) * LOG2E;
    int tid_ = F.tid; asm volatile("" : "+v"(tid_));
    const int tid = tid_, lane = tid & 63, wave = __builtin_amdgcn_readfirstlane(tid >> 6), r32 = lane & 31, hi = lane >> 5;
    const int q0 = qb * 256, qrel = wave * 32 + r32; const size_t tq = (size_t)b * S + q0 + qrel;
    LAS unsigned char* L = F.lds;
    const bf16* Qp; const bf16* Kp; const bf16* Vp; int kvpitch;
    if (TYPE == 0) { Qp = wsp<bf16>(F, WS_QM) + tq * 768 + h * 96; Kp = wsp<bf16>(F, WS_KVM) + h * 128; Vp = Kp + 64; kvpitch = 1024; }
    else if (TYPE == 1) { Qp = wsp<bf16>(F, WS_PROJ1) + tq * IN1P + h * 64; Kp = wsp<bf16>(F, WS_PROJ1) + 512 + h * 64; Vp = wsp<bf16>(F, WS_PROJ1) + 1024 + h * 64; kvpitch = IN1P; }
    else { Qp = wsp<bf16>(F, WS_PROJ1) + tq * IN1P + 1536 + h * 64; Kp = wsp<bf16>(F, WS_PROJ1) + 2048 + h * 64; Vp = wsp<bf16>(F, WS_PROJ1) + 2560 + h * 64; kvpitch = IN1P; }
    bf16x8_t qf[NC]; unsigned selmask = 0xffffffffu;
    { float qv[NC][8];
#pragma unroll
      for (int c = 0; c < NC; ++c) { const v4u w = *(const v4u*)(Qp + 16 * c + 8 * hi);
#pragma unroll
          for (int e = 0; e < 4; ++e) { qv[c][2 * e] = bflo(w[e]); qv[c][2 * e + 1] = bfhi(w[e]); } }
      if (TYPE == 0) { const float* rt = wsp<float>(F, WS_ROPE32) + (size_t)(q0 + qrel) * 32;
#pragma unroll
          for (int j = 0; j < 8; ++j) { const float c = rt[2 * (8 * hi + j)], s = rt[2 * (8 * hi + j) + 1], x1 = qv[NC - 2][j], x2 = qv[NC - 1][j]; qv[NC - 2][j] = x1 * c - x2 * s; qv[NC - 1][j] = x2 * c + x1 * s; } }
      if (TYPE == 2) {
          const float* km = wsp<float>(F, WS_KMEAN) + ((size_t)b * NH + h) * MOBA_NB * 64; LAS float* KL = (LAS float*)(F.lds + 120 * 1024);
          __syncthreads();
          for (int i = tid; i < qb * 64; i += NTHR) KL[i] = km[i];
          __syncthreads();
          float v0 = -INFINITY, v1 = -INFINITY, v2 = -INFINITY; int i0 = -1, i1 = -1, i2 = -1;
          for (int n = 0; n < qb; ++n) { float g = 0.f;
#pragma unroll
              for (int c = 0; c < NC; ++c) { const f32x4 ka = *(const LAS f32x4*)(KL + n * 64 + 16 * c + 8 * hi), kb2 = *(const LAS f32x4*)(KL + n * 64 + 16 * c + 8 * hi + 4);
                  g += (qv[c][0] * ka.x + qv[c][1] * ka.y) + (qv[c][2] * ka.z + qv[c][3] * ka.w) + (qv[c][4] * kb2.x + qv[c][5] * kb2.y) + (qv[c][6] * kb2.z + qv[c][7] * kb2.w); }
              g += __shfl_xor(g, 32);
              if (g > v0) { v2 = v1; i2 = i1; v1 = v0; i1 = i0; v0 = g; i0 = n; } else if (g > v1) { v2 = v1; i2 = i1; v1 = g; i1 = n; } else if (g > v2) { v2 = g; i2 = n; } }
          selmask = 1u << qb; if (i0 >= 0) selmask |= 1u << i0; if (i1 >= 0) selmask |= 1u << i1; if (i2 >= 0) selmask |= 1u << i2; }
#pragma unroll
      for (int c = 0; c < NC; ++c) { v4u w;
#pragma unroll
          for (int e = 0; e < 4; ++e) w[e] = cvtpk(qv[c][2 * e] * scale, qv[c][2 * e + 1] * scale);
          qf[c] = __builtin_bit_cast(bf16x8_t, w); } }
    float dq = 0.f; unsigned mask = selmask;
    if (TYPE == 1) dq = wsp<float>(F, WS_DCUM)[tq * 8 + h] * LOG2E;
    f32x16_t o0 = {}, o1 = {}; float m = 0.f, l = 0.f;
    const int nt = 4 * qb + 4;
    const int sr = tid >> 3, sc = tid & 7;
    const bf16* kg = Kp + ((size_t)b * S + sr) * kvpitch + sc * 8; const bf16* vg = Vp + ((size_t)b * S + sr) * kvpitch + sc * 8;
    const bf16* pg = wsp<bf16>(F, WS_KPE) + ((size_t)b * S + sr) * 32 + sc * 4; const float* dg = wsp<float>(F, WS_DCUM) + ((size_t)b * S + tid) * 8 + h;
    v4u kreg, vreg; v2u preg = {0u, 0u}; float dreg = 0.f;
#define AT_LOAD(s_) do { const int i_ = nt - 1 - (s_);     \
        kreg = *(const v4u*)(kg + (size_t)i_ * 64 * kvpitch); vreg = *(const v4u*)(vg + (size_t)i_ * 64 * kvpitch); \
        if (TYPE == 0) preg = *(const v2u*)(pg + (size_t)i_ * 64 * 32); if (TYPE == 1 && tid < 64) dreg = dg[(size_t)i_ * 64 * 8] * LOG2E; } while (0)
#define AT_WRITE(sl) do { *(LAS v4u*)(L + AK + (sl) * KBUF + sr * KSTR + sc * 16) = kreg; *(LAS v4u*)(L + AV + (sl) * VBUF + sr * VSTR + sc * 16) = vreg; \
        if (TYPE == 0) *(LAS v2u*)(L + AK + (sl) * KBUF + 64 * KSTR + sr * PSTR + sc * 8) = preg; if (TYPE == 1 && tid < 64) *(LAS float*)(L + AD + (sl) * 256 + tid * 4) = dreg; } while (0)
    const int kfoff = r32 * KSTR + hi * 16;
    const int vtoff = (4 * hi + ((lane & 15) >> 2)) * VSTR + (((lane >> 4) & 1) * 16 + (lane & 3) * 4) * 2;
#define AT_KF(sl) do { kslot = (sl); const LAS unsigned char* kb = L + AK + (sl) * KBUF + kfoff; \
        _Pragma("unroll") for (int c = 0; c < 4; ++c) { kf0[c] = *(const LAS bf16x8_t*)(kb + c * 32); kf1[c] = *(const LAS bf16x8_t*)(kb + 32 * KSTR + c * 32); } } while (0)
#define AT_CINIT(S0, S1, i, sl) do { \
        if (TYPE == 1) { const LAS float* Dk = (const LAS float*)(L + AD + (sl) * 256); const float dqm = dq - m; \
            _Pragma("unroll") for (int g = 0; g < 4; ++g) { const f32x4 d0 = *(const LAS f32x4*)(Dk + 8 * g + 4 * hi), d1 = *(const LAS f32x4*)(Dk + 32 + 8 * g + 4 * hi); \
                _Pragma("unroll") for (int e = 0; e < 4; ++e) { S0[4 * g + e] = dqm - d0[e]; S1[4 * g + e] = dqm - d1[e]; } } } \
        else { float bm = -m; if (TYPE == 2) bm = (((mask >> ((i) >> 2)) & 1u) ? 0.f : -1e30f) - m; \
            _Pragma("unroll") for (int r = 0; r < 16; ++r) { S0[r] = bm; S1[r] = bm; } } } while (0)
#define AT_QKM(S0, S1) do { _Pragma("unroll") for (int c = 0; c < 4; ++c) { S0 = __builtin_amdgcn_mfma_f32_32x32x16_bf16(kf0[c], qf[c], S0, 0, 0, 0); S1 = __builtin_amdgcn_mfma_f32_32x32x16_bf16(kf1[c], qf[c], S1, 0, 0, 0); } \
        if (TYPE == 0) { const LAS unsigned char* pb = L + AK + kslot * KBUF + 64 * KSTR + r32 * PSTR + hi * 16;     \
            _Pragma("unroll") for (int c = 0; c < 2; ++c) { const bf16x8_t k0 = *(const LAS bf16x8_t*)(pb + c * 32), k1 = *(const LAS bf16x8_t*)(pb + 32 * PSTR + c * 32); \
                S0 = __builtin_amdgcn_mfma_f32_32x32x16_bf16(k0, qf[4 + c], S0, 0, 0, 0); S1 = __builtin_amdgcn_mfma_f32_32x32x16_bf16(k1, qf[4 + c], S1, 0, 0, 0); } } } while (0)
    bf16x8_t kf0[4], kf1[4]; int kslot = 0;
    const bool grpB = wave >= 4;
    float qn = 0.f, rmax = -1e30f; LAS float* PK = (LAS float*)(L + 118 * 1024); volatile LAS unsigned* PF = (volatile LAS unsigned*)(L + 119 * 1024);
    if (TYPE == 1) {
        if (wave == 0) { const float* kn = wsp<float>(F, WS_KMEAN) + 65536 + ((size_t)b * NH + h) * 128; float v0 = 2 * lane < nt ? kn[2 * lane] : 0.f, v1 = fmaxf(v0, 2 * lane + 1 < nt ? kn[2 * lane + 1] : 0.f); float sc = v1;
#pragma unroll
            for (int o_ = 1; o_ < 64; o_ <<= 1) { const float n_ = __shfl_up(sc, o_); if (lane >= o_) sc = fmaxf(sc, n_); }
            const float prev = __shfl_up(sc, 1); PK[2 * lane] = fmaxf(lane > 0 ? prev : 0.f, v0); PK[2 * lane + 1] = sc; }
        float s2 = 0.f;
#pragma unroll
        for (int c = 0; c < NC; ++c) { const v4u w_ = __builtin_bit_cast(v4u, qf[c]);
#pragma unroll
            for (int e = 0; e < 4; ++e) { const float a_ = bflo(w_[e]), b_ = bfhi(w_[e]); s2 += a_ * a_ + b_ * b_; } }
        s2 += __shfl_xor(s2, 32); qn = sqrtf(s2) * 1.02f; }
    __syncthreads();
    AT_LOAD(0); AT_WRITE(0); AT_LOAD(1); AT_WRITE(1); AT_LOAD(2); AT_WRITE(2);
    __syncthreads();
    f32x16_t sc0, sc1, sn0, sn1;
    AT_KF(0); AT_CINIT(sc0, sc1, nt - 1, 0); AT_QKM(sc0, sc1);
    int s_cur = 0, s_nxt = 1, s_n2 = 2, s_far = 3;
    if (grpB) __syncthreads();
    for (int i = 0; i < nt; ++i) {
        if (TYPE == 1 && i > 0) { unsigned any = 0u;
#pragma unroll
            for (int w_ = 0; w_ < 8; ++w_) any |= PF[((i - 1) & 1) * 8 + w_];
            if (any == 0u) break; }
        if (i + 3 < nt) AT_LOAD(i + 3);
        AT_KF(s_nxt);
        s16x4_t va[4][2], vc[4][2];
        { const LAS unsigned char* vb = L + AV + s_cur * VBUF + vtoff;
#pragma unroll
          for (int ts = 0; ts < 4; ++ts)
#pragma unroll
              for (int db = 0; db < 2; ++db) { va[ts][db] = __builtin_bit_cast(s16x4_t, __builtin_amdgcn_ds_read_tr16_b64_v4i16((LAS s16x4_t*)(vb + ts * 16 * VSTR + db * 64)));
                  vc[ts][db] = __builtin_bit_cast(s16x4_t, __builtin_amdgcn_ds_read_tr16_b64_v4i16((LAS s16x4_t*)(vb + (ts * 16 + 8) * VSTR + db * 64))); } }
        AT_CINIT(sn0, sn1, nt - 2 - i, s_nxt);
        const int jb = 3 - i;
        if (jb >= 0 && 64 * jb + 63 > 32 * wave) {
#pragma unroll
            for (int r = 0; r < 16; ++r) { const int kv = 64 * jb + crow(r, hi); if (kv > qrel) sc0[r] = -1e30f; if (kv + 32 > qrel) sc1[r] = -1e30f; } }
        float mxa = fmaxf(fmaxf(sc0[0], sc0[1]), fmaxf(sc1[0], sc1[1])), mxb = fmaxf(fmaxf(sc0[2], sc0[3]), fmaxf(sc1[2], sc1[3]));
        float mxc = fmaxf(fmaxf(sc0[4], sc0[5]), fmaxf(sc1[4], sc1[5])), mxd = fmaxf(fmaxf(sc0[6], sc0[7]), fmaxf(sc1[6], sc1[7]));
#pragma unroll
        for (int r = 8; r < 16; r += 4) { mxa = fmaxf(mxa, fmaxf(sc0[r], sc1[r])); mxb = fmaxf(mxb, fmaxf(sc0[r + 1], sc1[r + 1])); mxc = fmaxf(mxc, fmaxf(sc0[r + 2], sc1[r + 2])); mxd = fmaxf(mxd, fmaxf(sc0[r + 3], sc1[r + 3])); }
        float mx = fmaxf(fmaxf(mxa, mxb), fmaxf(mxc, mxd));
        { auto rr = __builtin_amdgcn_permlane32_swap(__builtin_bit_cast(unsigned, mx), __builtin_bit_cast(unsigned, mx), false, false); mx = fmaxf(__builtin_bit_cast(float, rr[0]), __builtin_bit_cast(float, rr[1])); }
        if (TYPE == 1) rmax = fmaxf(rmax, mx);
        if (__builtin_expect(__ballot(mx > 8.0f) != 0ull, 0)) {
            const float dl = fmaxf(mx, 0.f), corr = __builtin_amdgcn_exp2f(-dl); m += dl; l *= corr; rmax -= dl;
#pragma unroll
            for (int r = 0; r < 16; ++r) { sc0[r] -= dl; sc1[r] -= dl; sn0[r] -= dl; sn1[r] -= dl; o0[r] *= corr; o1[r] *= corr; } }
#pragma unroll
        for (int r = 0; r < 16; ++r) { sc0[r] = __builtin_amdgcn_exp2f(sc0[r]); sc1[r] = __builtin_amdgcn_exp2f(sc1[r]); }
        float la = 0.f, lb = 0.f, lc = 0.f, ld = 0.f;
#pragma unroll
        for (int r = 0; r < 16; r += 2) { la += sc0[r]; lb += sc1[r]; lc += sc0[r + 1]; ld += sc1[r + 1]; }
        l += (la + lb) + (lc + ld);
        if (TYPE == 1) { const int tn = nt - 2 - i;
            bool need = false;
            if (tn >= 0) { const float dlast = *(const LAS float*)(L + AD + s_nxt * 256 + 63 * 4); need = (qn * PK[tn] + (dq - dlast) - m - rmax) > -40.0f; }
            const bool wn = __ballot(need) != 0ull; if (lane == 0) PF[(i & 1) * 8 + wave] = wn ? 1u : 0u; }
        __syncthreads();
        AT_QKM(sn0, sn1);
#pragma unroll
        for (int ts = 0; ts < 4; ++ts) { v4u pw; const int rb = 8 * (ts & 1);
            if (ts < 2) { pw.x = cvtpk(sc0[rb], sc0[rb + 1]); pw.y = cvtpk(sc0[rb + 2], sc0[rb + 3]); pw.z = cvtpk(sc0[rb + 4], sc0[rb + 5]); pw.w = cvtpk(sc0[rb + 6], sc0[rb + 7]); }
            else { pw.x = cvtpk(sc1[rb], sc1[rb + 1]); pw.y = cvtpk(sc1[rb + 2], sc1[rb + 3]); pw.z = cvtpk(sc1[rb + 4], sc1[rb + 5]); pw.w = cvtpk(sc1[rb + 6], sc1[rb + 7]); }
            const bf16x8_t pf = __builtin_bit_cast(bf16x8_t, pw);
            const bf16x8_t vf0 = (bf16x8_t){va[ts][0][0], va[ts][0][1], va[ts][0][2], va[ts][0][3], vc[ts][0][0], vc[ts][0][1], vc[ts][0][2], vc[ts][0][3]};
            const bf16x8_t vf1 = (bf16x8_t){va[ts][1][0], va[ts][1][1], va[ts][1][2], va[ts][1][3], vc[ts][1][0], vc[ts][1][1], vc[ts][1][2], vc[ts][1][3]};
            o0 = __builtin_amdgcn_mfma_f32_32x32x16_bf16(vf0, pf, o0, 0, 0, 0); o1 = __builtin_amdgcn_mfma_f32_32x32x16_bf16(vf1, pf, o1, 0, 0, 0); }
        if (i + 3 < nt) AT_WRITE(s_far);
        __syncthreads();
        sc0 = sn0; sc1 = sn1; { const int t_ = s_cur; s_cur = s_nxt; s_nxt = s_n2; s_n2 = s_far; s_far = t_; }
    }
    if (!grpB) __syncthreads();
#undef AT_KF
#undef AT_CINIT
#undef AT_QKM
#undef AT_LOAD
#undef AT_WRITE
#undef AT_QK
    l += __shfl_xor(l, 32); const float il = 1.0f / l;
    bf16* Op = wsp<bf16>(F, WS_YMIX) + tq * 1024 + (TYPE == 1 ? 0 : 512) + h * 64 + 4 * hi;
#pragma unroll
    for (int g = 0; g < 4; ++g) { v2u w0, w1; w0.x = cvtpk(o0[4 * g] * il, o0[4 * g + 1] * il); w0.y = cvtpk(o0[4 * g + 2] * il, o0[4 * g + 3] * il); w1.x = cvtpk(o1[4 * g] * il, o1[4 * g + 1] * il); w1.y = cvtpk(o1[4 * g + 2] * il, o1[4 * g + 3] * il);
        *(v2u*)(Op + 8 * g) = w0; *(v2u*)(Op + 32 + 8 * g) = w1; }
}
template <int TA, int TB> __device__ __forceinline__ void attn_queue_phase(const Frame& F, gu32* ctr) {
    constexpr int NT = TB >= 0 ? 2 : 1; volatile LAS unsigned* slot = (volatile LAS unsigned*)(F.lds + MISC_OFF + 64);
    constexpr int NU = NB * NH * 32 * NT; unsigned tkt = 0u; bool have = false;
    for (;;) {
        __syncthreads();
        if (F.tid == 0) *slot = have ? tkt : __hip_atomic_fetch_add(ctr, 1u, RLX_AGENT);
        __syncthreads();
        const int u = (int)__builtin_amdgcn_readfirstlane(*slot);
        if (u >= NU) break;
        have = u + 2 * F.G < NU; if (have && F.tid == 0) tkt = __hip_atomic_fetch_add(ctr, 1u, RLX_AGENT);
        const int qb = 31 - u / (NB * NH * NT), rest = u % (NB * NH * NT), ty = rest / (NB * NH), bh = rest % (NB * NH);
        if (NT == 1 || ty == 0) attn_unit<TA>(F, bh >> 3, bh & 7, qb); else attn_unit<(TB >= 0 ? TB : TA)>(F, bh >> 3, bh & 7, qb);
    }
}

constexpr int CK_P = 65, CK_PN = 68, CK_SLOT = 17408;
constexpr int CK_ITEMS = NB * NH * (S / 64);
#ifndef CK_BF16
#define CK_BF16 1
#endif
template <int XSR, int XSC, int YSR, int YSC> __device__ __forceinline__ void mm32(f32x16_t& acc, const LAS float* xp, const LAS float* yp, int lane) {
#if CK_BF16
    const int i = lane & 31, h8 = (lane >> 5) * 8; const LAS float* xa = xp + i * XSR + h8 * XSC; const LAS float* yb = yp + h8 * YSR + i * YSC;
#pragma unroll
    for (int ks = 0; ks < 4; ++ks) { float a[8], b[8];
#pragma unroll
        for (int j = 0; j < 8; ++j) { a[j] = xa[(16 * ks + j) * XSC]; b[j] = yb[(16 * ks + j) * YSR]; }
        v4u aw, bw;
#pragma unroll
        for (int e = 0; e < 4; ++e) { aw[e] = cvtpk(a[2 * e], a[2 * e + 1]); bw[e] = cvtpk(b[2 * e], b[2 * e + 1]); }
        acc = __builtin_amdgcn_mfma_f32_32x32x16_bf16(__builtin_bit_cast(bf16x8_t, aw), __builtin_bit_cast(bf16x8_t, bw), acc, 0, 0, 0); }
#else
    const int i = lane & 31, kk = lane >> 5; const LAS float* xa = xp + i * XSR + kk * XSC; const LAS float* yb = yp + kk * YSR + i * YSC;
#pragma unroll
    for (int s = 0; s < 32; ++s) acc = __builtin_amdgcn_mfma_f32_32x32x2f32(xa[2 * s * XSC], yb[2 * s * YSR], acc, 0, 0, 0);
#endif
}
struct CkRaw { v4u rw, kw, vw, ew, aw; };
__device__ __forceinline__ void ck_load(CkRaw& q, const bf16* RKV, const bf16* EW, const bf16* AA, size_t tok, int ch) {
    q.rw = *(const v4u*)(RKV + tok * 1536 + C_R + ch); q.kw = *(const v4u*)(RKV + tok * 1536 + C_K + ch); q.vw = *(const v4u*)(RKV + tok * 1536 + C_V + ch);
    q.ew = *(const v4u*)(EW + tok * 512 + ch); q.aw = *(const v4u*)(AA + tok * 512 + ch);
}
constexpr int CK_TBL = 7 * CK_SLOT + 1024;
__device__ __forceinline__ void ck_raw(const CkRaw& q, int ch, float (&rr)[8], float (&an)[8], float (&bb)[8], float (&kp)[8], float (&vv)[8], float (&ew)[8], const LAS float* ktab) {
    float kx[8], al[8], kk[8], ss = 0.f;
#pragma unroll
    for (int e = 0; e < 4; ++e) { rr[2 * e] = bflo(q.rw[e]); rr[2 * e + 1] = bfhi(q.rw[e]); kx[2 * e] = bflo(q.kw[e]); kx[2 * e + 1] = bfhi(q.kw[e]); vv[2 * e] = bflo(q.vw[e]); vv[2 * e + 1] = bfhi(q.vw[e]);
        ew[2 * e] = bflo(q.ew[e]); ew[2 * e + 1] = bfhi(q.ew[e]); al[2 * e] = bflo(q.aw[e]); al[2 * e + 1] = bfhi(q.aw[e]); }
    const LAS f32x4* kt4 = (const LAS f32x4*)(ktab + ch); const f32x4 kk0 = kt4[0], kk1 = kt4[1], ka0 = kt4[128], ka1 = kt4[129];
    const float kks[8] = {kk0.x, kk0.y, kk0.z, kk0.w, kk1.x, kk1.y, kk1.z, kk1.w}, kas[8] = {ka0.x, ka0.y, ka0.z, ka0.w, ka1.x, ka1.y, ka1.z, ka1.w};
#pragma unroll
    for (int e = 0; e < 8; ++e) { kk[e] = kx[e] * kks[e]; ss += kk[e] * kk[e]; }
    ss = sum8(ss); const float inv = 1.0f / fmaxf(sqrtf(ss), 1e-12f);
#pragma unroll
    for (int e = 0; e < 8; ++e) { const float kn = kk[e] * inv; an[e] = -kn; bb[e] = kn * al[e]; kp[e] = kx[e] * (1.0f + (al[e] - 1.0f) * kas[e]); }
}
__device__ __forceinline__ void rwkv_chunk_prep(const Frame& F, int item, const CkRaw& raw, CkRaw& nxt, int next_item) {
    const int c = item & 127, h = (item >> 7) & 7, b = item >> 10;
    int tid_ = F.tid; asm volatile("" : "+v"(tid_)); const int tid = tid_, lane = tid & 63, wave = __builtin_amdgcn_readfirstlane(tid >> 6), hi = lane >> 5, col = lane & 31;
    LAS float* R0 = (LAS float*)(F.lds); LAS float* R1 = (LAS float*)(F.lds + CK_SLOT); LAS float* R2 = (LAS float*)(F.lds + 2 * CK_SLOT); LAS float* R3 = (LAS float*)(F.lds + 3 * CK_SLOT);
    LAS float* R4 = (LAS float*)(F.lds + 4 * CK_SLOT); LAS float* R5 = (LAS float*)(F.lds + 5 * CK_SLOT); LAS float* R6 = (LAS float*)(F.lds + 6 * CK_SLOT); LAS float* GC = (LAS float*)(F.lds + 7 * CK_SLOT);
    const bf16* RKV = wsp<bf16>(F, WS_RKV); const bf16* EW = wsp<bf16>(F, WS_EW); const bf16* AA = wsp<bf16>(F, WS_AA);
    float* GZ = F.H + (size_t)item * 8192; bf16* QW = wsp<bf16>(F, WS_YRAW) + (size_t)item * 8192;
    const int t = tid >> 3, k8 = (tid & 7) * 8, ch = h * 64 + k8; const size_t tok = (size_t)b * S + c * 64 + t;
    { float rr[8], an[8], bb[8], kp[8], vv[8], ew[8]; ck_raw(raw, ch, rr, an, bb, kp, vv, ew, (const LAS float*)(F.lds + CK_TBL));
      __syncthreads();
      asm volatile("" :: "v"(raw.rw), "v"(raw.kw), "v"(raw.vw), "v"(raw.ew), "v"(raw.aw));
      if (next_item < CK_ITEMS) { const int c2 = next_item & 127, h2 = (next_item >> 7) & 7, b2 = next_item >> 10; ck_load(nxt, RKV, EW, AA, (size_t)b2 * S + c2 * 64 + t, h2 * 64 + k8); }
      { float cs[8]; const int tl = lane >> 3;
#pragma unroll
        for (int e = 0; e < 8; ++e) { float v = ew[e]; float n = __shfl_up(v, 8); if (tl >= 1) v += n; n = __shfl_up(v, 16); if (tl >= 2) v += n; n = __shfl_up(v, 32); if (tl >= 4) v += n; cs[e] = v; }
        if (tl == 7) {
#pragma unroll
            for (int e = 0; e < 8; ++e) R5[wave * 64 + k8 + e] = cs[e]; }
        __syncthreads();
        float off[8];
#pragma unroll
        for (int e = 0; e < 8; ++e) off[e] = 0.f;
        for (int w = 0; w < wave; ++w) {
#pragma unroll
            for (int e = 0; e < 8; ++e) off[e] += R5[w * 64 + k8 + e]; }
#pragma unroll
        for (int e = 0; e < 8; ++e) { cs[e] += off[e]; R6[t * CK_P + k8 + e] = cs[e]; }
        if (t == 63) {
#pragma unroll
            for (int e = 0; e < 8; ++e) { GC[k8 + e] = __expf(-cs[e]); GC[64 + k8 + e] = cs[e]; } } }
      __syncthreads();
#pragma unroll
      for (int e = 0; e < 8; ++e) { const float cl = R6[t * CK_P + k8 + e]; const float ep = __expf(cl), em = __expf(-cl), eme = __expf(-(cl - ew[e]));
          R0[t * CK_P + k8 + e] = an[e] * eme; R2[t * CK_P + k8 + e] = rr[e] * em; R3[t * CK_P + k8 + e] = bb[e] * ep; R4[t * CK_P + k8 + e] = kp[e] * ep; } }
    __syncthreads();
    const int bi = (wave >> 1) & 1, bj = wave & 1;
    { f32x16_t acc = {}; mm32<CK_P, 1, 1, CK_P>(acc, (wave < 4 ? R3 : R4) + bi * 32 * CK_P, R0 + bj * 32 * CK_P, lane);
#pragma unroll
      for (int r = 0; r < 16; ++r) { const int i = bi * 32 + crow(r, hi), tt = bj * 32 + col; (wave < 4 ? R5 + i * CK_PN : R1 + i * CK_P)[tt] = i < tt ? acc[r] : 0.f; } }
    __syncthreads();
    if (wave >= 4) { const int mat = (wave - 4) >> 1, ib = (wave - 4) & 1; LAS float* X = mat == 0 ? R3 : R4; f32x16_t a0 = {}, a1 = {};
        mm32<CK_P, 1, 1, CK_P>(a0, X + ib * 32 * CK_P, R2, lane); mm32<CK_P, 1, 1, CK_P>(a1, X + ib * 32 * CK_P, R2 + 32 * CK_P, lane);
#pragma unroll
        for (int r = 0; r < 16; ++r) { const int i = ib * 32 + crow(r, hi); X[i * CK_P + col] = i <= col ? a0[r] : 0.f; X[i * CK_P + 32 + col] = i <= 32 + col ? a1[r] : 0.f; }
    } else {
        const int row = tid >> 1, hf = tid & 1; LAS float* xb = row < 64 ? R0 + row : R1 + (row - 64) * CK_P; const int xs = row < 64 ? CK_P : 1;
#pragma unroll 1
        for (int B = 0; B < 4; ++B) { float acc[8];
#pragma unroll
            for (int j = 0; j < 8; ++j) acc[j] = xb[(16 * B + 8 * hf + j) * xs];
#pragma unroll 8
            for (int i = 0; i < 16 * B; ++i) { const float xi = xb[i * xs]; const LAS f32x4* nr = (const LAS f32x4*)(R5 + i * CK_PN + 16 * B + 8 * hf); const f32x4 n0 = nr[0], n1 = nr[1];
                acc[0] += xi * n0.x; acc[1] += xi * n0.y; acc[2] += xi * n0.z; acc[3] += xi * n0.w; acc[4] += xi * n1.x; acc[5] += xi * n1.y; acc[6] += xi * n1.z; acc[7] += xi * n1.w; }
#pragma unroll
            for (int jj = 0; jj < 15; ++jj) { const float own = acc[jj & 7], oth = dpp_mov<0xB1>(own); const float xj = hf == (jj >> 3) ? own : oth;
                const LAS f32x4* nr = (const LAS f32x4*)(R5 + (16 * B + jj) * CK_PN + 16 * B + 8 * hf); const f32x4 n0 = nr[0], n1 = nr[1];
                acc[0] += xj * n0.x; acc[1] += xj * n0.y; acc[2] += xj * n0.z; acc[3] += xj * n0.w; acc[4] += xj * n1.x; acc[5] += xj * n1.y; acc[6] += xj * n1.z; acc[7] += xj * n1.w; }
#pragma unroll
            for (int j = 0; j < 8; ++j) xb[(16 * B + 8 * hf + j) * xs] = acc[j]; }
    }
    __syncthreads();
    if (wave < 4) { f32x16_t acc;
#pragma unroll
        for (int r = 0; r < 16; ++r) acc[r] = R2[(bj * 32 + col) * CK_P + bi * 32 + crow(r, hi)];
        mm32<1, CK_P, CK_P, 1>(acc, R0 + bi * 32, R3 + bj * 32, lane);
#pragma unroll
        for (int r = 0; r < 16; ++r) QW[(bi * 32 + crow(r, hi)) * 64 + bj * 32 + col] = (bf16)f2bf(acc[r]);
    } else { f32x16_t acc;
#pragma unroll
        for (int r = 0; r < 16; ++r) acc[r] = R4[(bi * 32 + crow(r, hi)) * CK_P + bj * 32 + col];
        mm32<CK_P, 1, CK_P, 1>(acc, R1 + bi * 32 * CK_P, R3 + bj * 32, lane);
#pragma unroll
        for (int r = 0; r < 16; ++r) R4[(bi * 32 + crow(r, hi)) * CK_P + bj * 32 + col] = acc[r]; }
    __syncthreads();
    { float rr[8], an[8], bb[8], kp[8], vv[8], ew[8]; ck_raw(raw, ch, rr, an, bb, kp, vv, ew, (const LAS float*)(F.lds + CK_TBL));
#pragma unroll
      for (int e = 0; e < 8; ++e) { const float eh = __expf(-(GC[64 + k8 + e] - R6[t * CK_P + k8 + e])); R2[t * CK_P + k8 + e] = bb[e] * eh; R5[t * CK_P + k8 + e] = kp[e] * eh; R3[t * CK_P + k8 + e] = vv[e]; } }
    __syncthreads();
    if (wave < 4) { f32x16_t acc;
#pragma unroll
        for (int r = 0; r < 16; ++r) acc[r] = 0.f;
        mm32<1, CK_P, CK_P, 1>(acc, R0 + bi * 32, R2 + bj * 32, lane);
        if (wave == 0) wsp<float>(F, WS_SSQ)[(size_t)item * 64 + lane] = GC[lane];
#pragma unroll
        for (int r = 0; r < 16; ++r) GZ[(bi * 32 + crow(r, hi)) * 64 + bj * 32 + col] = acc[r];
    } else { f32x16_t acc;
#pragma unroll
        for (int r = 0; r < 16; ++r) acc[r] = R5[(bi * 32 + crow(r, hi)) * CK_P + bj * 32 + col];
        mm32<CK_P, 1, CK_P, 1>(acc, R1 + bi * 32 * CK_P, R2 + bj * 32, lane);
#pragma unroll
        for (int r = 0; r < 16; ++r) R5[(bi * 32 + crow(r, hi)) * CK_P + bj * 32 + col] = acc[r]; }
    __syncthreads();
    { f32x16_t acc = {}; mm32<1, CK_P, CK_P, 1>(acc, R3 + bi * 32, (wave < 4 ? R5 : R4) + bj * 32, lane);
      if (wave < 4) {
#pragma unroll
          for (int r = 0; r < 16; ++r) GZ[4096 + (bi * 32 + crow(r, hi)) * 64 + bj * 32 + col] = acc[r];
      } else {
#pragma unroll
          for (int r = 0; r < 16; ++r) QW[4096 + (bi * 32 + crow(r, hi)) * 64 + bj * 32 + col] = (bf16)f2bf(acc[r]); } }
}
__device__ __forceinline__ void rwkv_chunk_scan(const Frame& F, int bh) {
    const int b = bh >> 3, h = bh & 7;
    int tid_ = F.tid; asm volatile("" : "+v"(tid_)); const int tid = tid_, lane = tid & 63, wave = __builtin_amdgcn_readfirstlane(tid >> 6), hi = lane >> 5, col = lane & 31;
    LAS float* SA = (LAS float*)(F.lds); LAS float* SB = (LAS float*)(F.lds + CK_SLOT); LAS float* GL = (LAS float*)(F.lds + 2 * CK_SLOT); LAS float* QL = (LAS float*)(F.lds + 3 * CK_SLOT); LAS float* YL = (LAS float*)(F.lds + 4 * CK_SLOT);
    const bf16* RKV = wsp<bf16>(F, WS_RKV); const bf16* AA = wsp<bf16>(F, WS_AA); const bf16* GG = wsp<bf16>(F, WS_GG); bf16* YM = wsp<bf16>(F, WS_YMIX);
    const int bi = (wave >> 1) & 1, bj = wave & 1;
    __syncthreads();
    for (int i = tid; i < 64 * CK_P; i += NTHR) SA[i] = 0.f;
    const int pt = tid >> 3, pk = (tid & 7) * 8, pch = h * 64 + pk;
    float ka[8], rk[8], lg[8], lb[8];
#pragma unroll
    for (int e = 0; e < 8; ++e) { ka[e] = kin(10)[pch + e]; rk[e] = kin(11)[pch + e]; lg[e] = kin(12)[pch + e]; lb[e] = kin(13)[pch + e]; }
    f32x4 g0, g1; v4u q1;
    const float* GCv = wsp<float>(F, WS_SSQ) + (size_t)(bh * 128) * 64; const float* GZ0 = F.H + (size_t)(bh * 128) * 8192; const bf16* QW0 = wsp<bf16>(F, WS_YRAW) + (size_t)(bh * 128) * 8192;
#define CS_LOAD(c_) do { const float* gp = GZ0 + (size_t)(c_) * 8192 + (tid >> 3) * 64 + (tid & 7) * 8; g0 = *(const f32x4*)gp; g1 = *(const f32x4*)(gp + 4); q1 = *(const v4u*)(QW0 + (size_t)(c_) * 8192 + (tid >> 3) * 64 + (tid & 7) * 8); } while (0)
    CS_LOAD(0);
    v4u prw, pkw, pvw, paw, pgw;
    { const size_t t0_ = (size_t)b * S + pt; prw = *(const v4u*)(RKV + t0_ * 1536 + C_R + pch); pkw = *(const v4u*)(RKV + t0_ * 1536 + C_K + pch); pvw = *(const v4u*)(RKV + t0_ * 1536 + C_V + pch);
      paw = *(const v4u*)(AA + t0_ * 512 + pch); pgw = *(const v4u*)(GG + t0_ * 512 + pch); }
    float cin[16];
#define CS_CIN(c_) do { if (wave < 4) { const float* zp = GZ0 + (size_t)(c_) * 8192 + 4096 + (bi * 32) * 64 + bj * 32 + col; \
            _Pragma("unroll") for (int r = 0; r < 16; ++r) cin[r] = zp[crow(r, hi) * 64]; } \
        else { const bf16* wp = QW0 + (size_t)(c_) * 8192 + 4096 + (bi * 32) * 64 + bj * 32 + col; \
            _Pragma("unroll") for (int r = 0; r < 16; ++r) cin[r] = bf1(wp[crow(r, hi) * 64]); } } while (0)
    CS_CIN(0);
    for (int c = 0; c < 128; ++c) {
        LAS float* Sc = (c & 1) ? SB : SA; LAS float* Sn = (c & 1) ? SA : SB;
        { LAS float* gd = GL + (tid >> 3) * CK_P + (tid & 7) * 8; LAS float* qd = QL + (tid >> 3) * CK_P + (tid & 7) * 8;
#pragma unroll
          for (int e = 0; e < 4; ++e) { gd[e] = g0[e]; gd[4 + e] = g1[e]; qd[2 * e] = bflo(q1[e]); qd[2 * e + 1] = bfhi(q1[e]); } }
        __syncthreads();
        asm volatile("" :: "v"(prw), "v"(pkw), "v"(pvw), "v"(paw), "v"(pgw));
#pragma unroll
        for (int r = 0; r < 16; ++r) asm volatile("" :: "v"(cin[r]));
        if (c + 1 < 128) CS_LOAD(c + 1);
        const size_t tok = (size_t)b * S + c * 64 + pt;
        const v4u rw = prw, kw = pkw, vw = pvw, aw = paw, gw4 = pgw;
        if (c + 1 < 128) { const size_t tn = tok + 64; prw = *(const v4u*)(RKV + tn * 1536 + C_R + pch); pkw = *(const v4u*)(RKV + tn * 1536 + C_K + pch); pvw = *(const v4u*)(RKV + tn * 1536 + C_V + pch);
            paw = *(const v4u*)(AA + tn * 512 + pch); pgw = *(const v4u*)(GG + tn * 512 + pch); }
        { f32x16_t acc;
#pragma unroll
          for (int r = 0; r < 16; ++r) acc[r] = cin[r];
          if (wave < 4) { const float gc = GCv[(size_t)c * 64 + bj * 32 + col];
#pragma unroll
              for (int r = 0; r < 16; ++r) acc[r] += Sc[(bi * 32 + crow(r, hi)) * CK_P + bj * 32 + col] * gc; }
          if (c + 1 < 128) CS_CIN(c + 1);
          mm32<CK_P, 1, CK_P, 1>(acc, Sc + bi * 32 * CK_P, (wave < 4 ? GL : QL) + bj * 32, lane);
#pragma unroll
          for (int r = 0; r < 16; ++r) { const int j = bi * 32 + crow(r, hi), q = bj * 32 + col; (wave < 4 ? Sn + j * CK_P + q : YL + q * CK_P + j)[0] = acc[r]; } }
        __syncthreads();
        {
          float y[8], r[8], k[8], v[8], al[8], g[8];
#pragma unroll
          for (int e = 0; e < 8; ++e) y[e] = YL[pt * CK_P + pk + e];
#pragma unroll
          for (int e = 0; e < 4; ++e) { r[2 * e] = bflo(rw[e]); r[2 * e + 1] = bfhi(rw[e]); k[2 * e] = bflo(kw[e]); k[2 * e + 1] = bfhi(kw[e]); v[2 * e] = bflo(vw[e]); v[2 * e + 1] = bfhi(vw[e]);
              al[2 * e] = bflo(aw[e]); al[2 * e + 1] = bfhi(aw[e]); g[2 * e] = bflo(gw4[e]); g[2 * e + 1] = bfhi(gw4[e]); }
          float s = 0.f, bs = 0.f;
#pragma unroll
          for (int e = 0; e < 8; ++e) { s += y[e]; const float kq = k[e] * (1.0f + (al[e] - 1.0f) * ka[e]); bs += r[e] * kq * rk[e]; }
          s = sum8(s); bs = sum8(bs);
          const float mean = s * (1.f / 64.f); float q = 0.f;
#pragma unroll
          for (int e = 0; e < 8; ++e) { const float d = y[e] - mean; q += d * d; }
          q = sum8(q);
          const float rstd = 1.0f / sqrtf(q * (1.f / 64.f) + GN_EPS); v4u o;
#pragma unroll
          for (int e = 0; e < 4; ++e) { const float o0 = ((y[2 * e] - mean) * rstd * lg[2 * e] + lb[2 * e] + bs * v[2 * e]) * g[2 * e], o1 = ((y[2 * e + 1] - mean) * rstd * lg[2 * e + 1] + lb[2 * e + 1] + bs * v[2 * e + 1]) * g[2 * e + 1]; o[e] = pk2(o0, o1); }
          *(v4u*)(YM + tok * 1024 + pch) = o; }
    }
#undef CS_LOAD
#undef CS_CIN
}

constexpr int MB_KSTR = 144, MB_VSTR = 192, MB_V = 256 * MB_KSTR, MB_END = MB_V + 256 * MB_VSTR;
constexpr int MB_LISTS = NB * NH * 31, MB_BHCAP = 126976, MB_PARTQ = 1024;
constexpr int MB_PU_OFF = 124 * 1024;
__device__ __forceinline__ int moba_off(int j) { return 256 * (31 * j - (j * (j - 1)) / 2); }
__device__ __forceinline__ void p13_moba_select(const Frame& F) {
    const int tid = F.tid, lane = tid & 63, wave = __builtin_amdgcn_readfirstlane(tid >> 6), r32 = lane & 31, hi = lane >> 5;
    LAS float* KL = (LAS float*)F.lds; LAS unsigned* lcnt = (LAS unsigned*)(F.lds + 8192); LAS unsigned* lbase = (LAS unsigned*)(F.lds + 8192 + 128);
    const bf16* P = wsp<bf16>(F, WS_PROJ1); const float* KM = wsp<float>(F, WS_KMEAN); unsigned* QL = wsp<unsigned>(F, WS_QLIST); gu32* CNT = (gu32*)(F.ws + WS_CTL) + CW_MOBA;
    for (int it = F.bid; it < NB * NH * 32; it += F.G) { const int bh = it >> 5, qb = ((it & 31) + 8 * (bh >> 3)) & 31, b = bh >> 3, h = bh & 7; if (qb == 0) continue;
        const int qpos = qb * 256 + wave * 32 + r32; const size_t tq = (size_t)b * S + qpos;
        float qv[4][8];
#pragma unroll
        for (int c = 0; c < 4; ++c) { const v4u w = *(const v4u*)(P + tq * IN1P + 1536 + h * 64 + 16 * c + 8 * hi);
#pragma unroll
            for (int e = 0; e < 4; ++e) { qv[c][2 * e] = bflo(w[e]); qv[c][2 * e + 1] = bfhi(w[e]); } }
        __syncthreads();
        { const float* km = KM + (size_t)bh * MOBA_NB * 64; for (int i = tid; i < qb * 64; i += NTHR) KL[i] = km[i]; if (tid < 32) lcnt[tid] = 0u; }
        __syncthreads();
        float v0 = -INFINITY, v1 = -INFINITY, v2 = -INFINITY; int i0 = -1, i1 = -1, i2 = -1;
        for (int n = 0; n < qb; ++n) { float g = 0.f;
#pragma unroll
            for (int c = 0; c < 4; ++c) { const f32x4 ka = *(const LAS f32x4*)(KL + n * 64 + 16 * c + 8 * hi), kb2 = *(const LAS f32x4*)(KL + n * 64 + 16 * c + 8 * hi + 4);
                g += (qv[c][0] * ka.x + qv[c][1] * ka.y) + (qv[c][2] * ka.z + qv[c][3] * ka.w) + (qv[c][4] * kb2.x + qv[c][5] * kb2.y) + (qv[c][6] * kb2.z + qv[c][7] * kb2.w); }
            g += __shfl_xor(g, 32);
            if (g > v0) { v2 = v1; i2 = i1; v1 = v0; i1 = i0; v0 = g; i0 = n; } else if (g > v1) { v2 = v1; i2 = i1; v1 = g; i1 = n; } else if (g > v2) { v2 = g; i2 = n; } }
        unsigned r0 = 0u, r1 = 0u, r2 = 0u;
        if (hi == 0) { if (i0 >= 0) r0 = __hip_atomic_fetch_add(lcnt + i0, 1u, __ATOMIC_RELAXED, __HIP_MEMORY_SCOPE_WORKGROUP); if (i1 >= 0) r1 = __hip_atomic_fetch_add(lcnt + i1, 1u, __ATOMIC_RELAXED, __HIP_MEMORY_SCOPE_WORKGROUP);
            if (i2 >= 0) r2 = __hip_atomic_fetch_add(lcnt + i2, 1u, __ATOMIC_RELAXED, __HIP_MEMORY_SCOPE_WORKGROUP); }
        __syncthreads();
        if (tid < 31) { const unsigned c = lcnt[tid]; lbase[tid] = c ? __hip_atomic_fetch_add(CNT + bh * 32 + tid, c, RLX_AGENT) : 0u; }
        __syncthreads();
        if (hi == 0) { unsigned* ql = QL + (size_t)bh * MB_BHCAP;
            if (i0 >= 0) ql[moba_off(i0) + lbase[i0] + r0] = (unsigned)qpos; if (i1 >= 0) ql[moba_off(i1) + lbase[i1] + r1] = (unsigned)qpos | (1u << 16); if (i2 >= 0) ql[moba_off(i2) + lbase[i2] + r2] = (unsigned)qpos | (2u << 16); }
    }
}
__device__ __forceinline__ void moba_unit(const Frame& F, int bh, int j, const unsigned* ql0, int nq, bool own, bool load = true) {
    constexpr float LOG2E = 1.4426950408889634f; const float scale = 0.125f * LOG2E;
    int tid_ = F.tid; asm volatile("" : "+v"(tid_)); const int tid = tid_, lane = tid & 63, wave = __builtin_amdgcn_readfirstlane(tid >> 6), r32 = lane & 31, hi = lane >> 5;
    const int b = bh >> 3, h = bh & 7; LAS unsigned char* L = F.lds;
    const bf16* P = wsp<bf16>(F, WS_PROJ1); bf16* PO = wsp<bf16>(F, WS_PARTO); float* PML = wsp<float>(F, WS_PARTML);
    if (load) {
    __syncthreads();
    { const bf16* kg = P + ((size_t)b * S + j * 256) * IN1P + 2048 + h * 64; const bf16* vg = P + ((size_t)b * S + j * 256) * IN1P + 2560 + h * 64;
#pragma unroll
      for (int u = 0; u < 4; ++u) { const int pc = tid + u * NTHR, row = pc >> 3, sc = pc & 7; const v4u kw = *(const v4u*)(kg + (size_t)row * IN1P + sc * 8), vw = *(const v4u*)(vg + (size_t)row * IN1P + sc * 8);
          *(LAS v4u*)(L + row * MB_KSTR + sc * 16) = kw; *(LAS v4u*)(L + MB_V + row * MB_VSTR + sc * 16) = vw; } }
    __syncthreads();
    }
    const int kfoff = r32 * MB_KSTR + hi * 16, vtoff = MB_V + (4 * hi + ((lane & 15) >> 2)) * MB_VSTR + (((lane >> 4) & 1) * 16 + (lane & 3) * 4) * 2;
    const int ng = (nq + 31) >> 5;
    for (int g = wave; g < ng; g += NWAVES) {
        const int idx = g * 32 + r32; const bool valid = idx < nq; const int ic = valid ? idx : nq - 1;
        const unsigned ent = own ? ((unsigned)(j * 256 + ic) | (3u << 16)) : ql0[ic]; const int qpos = (int)(ent & 0xffffu), slot = (int)(ent >> 16); const size_t tq = (size_t)b * S + qpos;
        bf16x8_t qf[4];
#pragma unroll
        for (int c = 0; c < 4; ++c) { const v4u w = *(const v4u*)(P + tq * IN1P + 1536 + h * 64 + 16 * c + 8 * hi); v4u o;
#pragma unroll
            for (int e = 0; e < 4; ++e) o[e] = cvtpk(bflo(w[e]) * scale, bfhi(w[e]) * scale);
            qf[c] = __builtin_bit_cast(bf16x8_t, o); }
        f32x16_t o0 = {}, o1 = {}; float m = 0.f, l = 0.f;
        const int tlast = own ? ((g * 32 + 31) >> 6) : 3;
#pragma unroll 1
        for (int t = 0; t <= tlast; ++t) {
            f32x16_t s0, s1;
#pragma unroll
            for (int r = 0; r < 16; ++r) { s0[r] = -m; s1[r] = -m; }
            const LAS unsigned char* kb = L + (64 * t) * MB_KSTR + kfoff;
#pragma unroll
            for (int c = 0; c < 4; ++c) { const bf16x8_t k0 = *(const LAS bf16x8_t*)(kb + c * 32), k1 = *(const LAS bf16x8_t*)(kb + 32 * MB_KSTR + c * 32);
                s0 = __builtin_amdgcn_mfma_f32_32x32x16_bf16(k0, qf[c], s0, 0, 0, 0); s1 = __builtin_amdgcn_mfma_f32_32x32x16_bf16(k1, qf[c], s1, 0, 0, 0); }
            if (own) {
#pragma unroll
                for (int r = 0; r < 16; ++r) { const int kv = 64 * t + crow(r, hi); if (kv > ic) s0[r] = -1e30f; if (kv + 32 > ic) s1[r] = -1e30f; } }
            float mxa = fmaxf(fmaxf(s0[0], s0[1]), fmaxf(s1[0], s1[1])), mxb = fmaxf(fmaxf(s0[2], s0[3]), fmaxf(s1[2], s1[3]));
#pragma unroll
            for (int r = 4; r < 16; r += 2) { mxa = fmaxf(mxa, fmaxf(s0[r], s1[r])); mxb = fmaxf(mxb, fmaxf(s0[r + 1], s1[r + 1])); }
            float mx = fmaxf(mxa, mxb);
            { auto rr = __builtin_amdgcn_permlane32_swap(__builtin_bit_cast(unsigned, mx), __builtin_bit_cast(unsigned, mx), false, false); mx = fmaxf(__builtin_bit_cast(float, rr[0]), __builtin_bit_cast(float, rr[1])); }
            if (__ballot(mx > 8.0f) != 0ull) { const float dl = fmaxf(mx, 0.f), corr = __builtin_amdgcn_exp2f(-dl); m += dl; l *= corr;
#pragma unroll
                for (int r = 0; r < 16; ++r) { s0[r] -= dl; s1[r] -= dl; o0[r] *= corr; o1[r] *= corr; } }
            float la = 0.f, lb = 0.f;
#pragma unroll
            for (int r = 0; r < 16; ++r) { s0[r] = __builtin_amdgcn_exp2f(s0[r]); s1[r] = __builtin_amdgcn_exp2f(s1[r]); la += s0[r]; lb += s1[r]; }
            l += la + lb;
            const LAS unsigned char* vb = L + vtoff + (64 * t) * MB_VSTR;
#pragma unroll
            for (int ts = 0; ts < 4; ++ts) { v4u pw; const int rb = 8 * (ts & 1);
                if (ts < 2) { pw.x = cvtpk(s0[rb], s0[rb + 1]); pw.y = cvtpk(s0[rb + 2], s0[rb + 3]); pw.z = cvtpk(s0[rb + 4], s0[rb + 5]); pw.w = cvtpk(s0[rb + 6], s0[rb + 7]); }
                else { pw.x = cvtpk(s1[rb], s1[rb + 1]); pw.y = cvtpk(s1[rb + 2], s1[rb + 3]); pw.z = cvtpk(s1[rb + 4], s1[rb + 5]); pw.w = cvtpk(s1[rb + 6], s1[rb + 7]); }
                const bf16x8_t pf = __builtin_bit_cast(bf16x8_t, pw);
#pragma unroll
                for (int db = 0; db < 2; ++db) {
                    const s16x4_t a = __builtin_bit_cast(s16x4_t, __builtin_amdgcn_ds_read_tr16_b64_v4i16((LAS s16x4_t*)(vb + ts * 16 * MB_VSTR + db * 64)));
                    const s16x4_t c = __builtin_bit_cast(s16x4_t, __builtin_amdgcn_ds_read_tr16_b64_v4i16((LAS s16x4_t*)(vb + (ts * 16 + 8) * MB_VSTR + db * 64)));
                    const bf16x8_t vf = (bf16x8_t){a[0], a[1], a[2], a[3], c[0], c[1], c[2], c[3]};
                    if (db == 0) o0 = __builtin_amdgcn_mfma_f32_32x32x16_bf16(vf, pf, o0, 0, 0, 0); else o1 = __builtin_amdgcn_mfma_f32_32x32x16_bf16(vf, pf, o1, 0, 0, 0); } }
        }
        l += __shfl_xor(l, 32); const float il = 1.0f / l;
        const size_t pidx = (tq * 8 + h) * 4 + slot;
        if (valid) { bf16* Op = PO + pidx * 64 + 4 * hi;
#pragma unroll
            for (int gq = 0; gq < 4; ++gq) { v2u w0, w1; w0.x = cvtpk(o0[4 * gq] * il, o0[4 * gq + 1] * il); w0.y = cvtpk(o0[4 * gq + 2] * il, o0[4 * gq + 3] * il); w1.x = cvtpk(o1[4 * gq] * il, o1[4 * gq + 1] * il); w1.y = cvtpk(o1[4 * gq + 2] * il, o1[4 * gq + 3] * il);
                *(v2u*)(Op + 8 * gq) = w0; *(v2u*)(Op + 32 + 8 * gq) = w1; }
            if (hi == 0) { PML[pidx * 2] = m; PML[pidx * 2 + 1] = l; } }
    }
}
__device__ __forceinline__ void layer1_attn_phase(const Frame& F, gu32* ctr) {
    volatile LAS unsigned* slot = (volatile LAS unsigned*)(F.lds + MISC_OFF + 64); LAS int* PU = (LAS int*)(F.lds + MB_PU_OFF); LAS int* BT = (LAS int*)(F.lds + MB_PU_OFF + 4096);
    gu32* CNT = (gu32*)(F.ws + WS_CTL) + CW_MOBA;
    LAS int* CL = (LAS int*)F.lds;
    __syncthreads();
    for (int i = F.tid; i < NB * NH * 32; i += NTHR) { const int np_ = (i & 31) < 31 ? ((int)__hip_atomic_load(CNT + i, RLX_AGENT) + MB_PARTQ - 1) / MB_PARTQ : 0; CL[i] = np_ > 1 ? np_ - 1 : 0; }
    __syncthreads();
    if (F.tid < 32) { int s = 0; for (int j = 0; j < 31; ++j) s += CL[F.tid * 32 + j]; BT[F.tid] = s; }
    __syncthreads();
    for (int id = F.tid; id < MB_LISTS; id += NTHR) { const int bh = id / 31, j = id % 31; int s = 0; for (int k = 0; k < bh; ++k) s += BT[k];
        for (int k = 0; k < j; ++k) s += CL[bh * 32 + k]; PU[id] = s; }
    if (F.tid == 0) { int s = 0; for (int k = 0; k < 32; ++k) s += BT[k]; PU[MB_LISTS] = s; }
    __syncthreads();
    const int NF = NB * NH * 32, NO = NB * NH * 32, NGU = PU[MB_LISTS];
    unsigned tkt = 0u; bool have = false;
    for (;;) {
        __syncthreads();
        if (F.tid == 0) *slot = have ? tkt : __hip_atomic_fetch_add(ctr, 1u, RLX_AGENT);
        __syncthreads();
        const int u = (int)__builtin_amdgcn_readfirstlane(*slot);
        if (u >= NF + NO + NGU) break;
        have = u + 2 * F.G < NF + NO + NGU; if (have && F.tid == 0) tkt = __hip_atomic_fetch_add(ctr, 1u, RLX_AGENT);
        if (u < NF) { const int qb = 31 - u / (NB * NH), bh = u % (NB * NH); attn_unit<1>(F, bh >> 3, bh & 7, qb); }
        else if (u >= NF + NGU) { const int m_ = u - NF - NGU, qb = m_ / (NB * NH), bh = m_ % (NB * NH); moba_unit(F, bh, qb, nullptr, 256, true);
            if (qb < 31) { const int cnt = (int)__builtin_amdgcn_readfirstlane((int)__hip_atomic_load(CNT + bh * 32 + qb, RLX_AGENT));
                if (cnt > 0) moba_unit(F, bh, qb, wsp<unsigned>(F, WS_QLIST) + (size_t)bh * MB_BHCAP + moba_off(qb), cnt < MB_PARTQ ? cnt : MB_PARTQ, false, false); } }
        else { const int gidx = u - NF; int lo = 0, hi_ = MB_LISTS;
            while (hi_ - lo > 1) { const int mid = (lo + hi_) >> 1; if (PU[mid] <= gidx) lo = mid; else hi_ = mid; }
            const int bh = lo / 31, j = lo % 31, part = gidx - PU[lo] + 1; const int cnt = (int)__builtin_amdgcn_readfirstlane((int)__hip_atomic_load(CNT + bh * 32 + j, RLX_AGENT));
            const int q0 = part * MB_PARTQ, nq = cnt - q0 < MB_PARTQ ? cnt - q0 : MB_PARTQ;
            moba_unit(F, bh, j, wsp<unsigned>(F, WS_QLIST) + (size_t)bh * MB_BHCAP + moba_off(j) + q0, nq, false); }
    }
}
__device__ __forceinline__ void p14_moba_combine(const Frame& F) {
    const int gw = F.bid * NWAVES + F.wave, NGW = F.G * NWAVES, lane = F.lane, h = lane >> 3, d8 = (lane & 7) * 8;
    const bf16* PO = wsp<bf16>(F, WS_PARTO); const float* PML = wsp<float>(F, WS_PARTML); bf16* YM = wsp<bf16>(F, WS_YMIX);
    for (int t = gw; t < T; t += NGW) { const int own = (t % S) >> 8, nv = own < 3 ? own : 3; const size_t p0 = ((size_t)t * 8 + h) * 4;
        float mm[4], ll[4]; v4u ov[4]; float M = -1e30f;
#pragma unroll
        for (int s = 0; s < 4; ++s) { const bool use = s == 3 || s < nv; mm[s] = -1e30f; ll[s] = 0.f; ov[s] = (v4u){0u, 0u, 0u, 0u};
            if (use) { mm[s] = PML[(p0 + s) * 2]; ll[s] = PML[(p0 + s) * 2 + 1]; ov[s] = *(const v4u*)(PO + (p0 + s) * 64 + d8); M = fmaxf(M, mm[s]); } }
        float acc[8], wsum = 0.f;
#pragma unroll
        for (int e = 0; e < 8; ++e) acc[e] = 0.f;
#pragma unroll
        for (int s = 0; s < 4; ++s) { const float w = ll[s] * __builtin_amdgcn_exp2f(mm[s] - M); wsum += w;
#pragma unroll
            for (int e = 0; e < 4; ++e) { acc[2 * e] += w * bflo(ov[s][e]); acc[2 * e + 1] += w * bfhi(ov[s][e]); } }
        const float iw = 1.0f / wsum; v4u o;
#pragma unroll
        for (int e = 0; e < 4; ++e) o[e] = pk2(acc[2 * e] * iw, acc[2 * e + 1] * iw);
        *(v4u*)(YM + (size_t)t * 1024 + 512 + h * 64 + d8) = o; }
}

__device__ __forceinline__ void p11_dcum(const Frame& F) {
    if (F.bid >= NB * NH) return;
    const int b = F.bid >> 3, h = F.bid & 7, tid = F.tid, lane = F.lane; LAS float* ws = (LAS float*)F.lds;
    const float* LF = wsp<float>(F, WS_LOGF) + ((size_t)b * S) * 8 + h; float* DC = wsp<float>(F, WS_DCUM) + ((size_t)b * S) * 8 + h;
    static_assert(S == NTHR * 16, "dcum: 16 steps per thread");
    float v[16];
#pragma unroll
    for (int j = 0; j < 16; ++j) v[j] = LF[(size_t)(tid * 16 + j) * 8];
#pragma unroll
    for (int j = 1; j < 16; ++j) v[j] += v[j - 1];
    float inc = v[15];
#pragma unroll
    for (int o = 1; o < 64; o <<= 1) { const float n = __shfl_up(inc, o); if (lane >= o) inc += n; }
    if (lane == 63) ws[F.wave] = inc;
    __syncthreads();
    float off = inc - v[15];
    for (int w = 0; w < F.wave; ++w) off += ws[w];
#pragma unroll
    for (int j = 0; j < 16; ++j) DC[(size_t)(tid * 16 + j) * 8] = v[j] + off;
}
__device__ __forceinline__ void p11_knorm(const Frame& F) {
    const int gw = F.bid * NWAVES + F.wave, NGW = F.G * NWAVES, lane = F.lane; const bf16* P = wsp<bf16>(F, WS_PROJ1); float* KN = wsp<float>(F, WS_KMEAN) + 65536;
    for (int it = gw; it < NB * NH * 128; it += NGW) { const int tile = it & 127, h = (it >> 7) & 7, b = it >> 10; const bf16* kp = P + ((size_t)b * S + tile * 64 + lane) * IN1P + 512 + h * 64; float s2 = 0.f;
#pragma unroll
        for (int c = 0; c < 8; ++c) { const v4u w = *(const v4u*)(kp + 8 * c);
#pragma unroll
            for (int e = 0; e < 4; ++e) { const float a0 = bflo(w[e]), a1 = bfhi(w[e]); s2 += a0 * a0 + a1 * a1; } }
#pragma unroll
        for (int o = 1; o < 64; o <<= 1) s2 = fmaxf(s2, __shfl_xor(s2, o));
        if (lane == 0) KN[it] = sqrtf(s2); }
}
__device__ __forceinline__ void p11_moba_rope(const Frame& F) {
    const int tid = F.tid, lane = tid & 63, wave = __builtin_amdgcn_readfirstlane(tid >> 6); LAS float* L = (LAS float*)F.lds;
    const int l5 = lane & 31, par = lane >> 5, ten = l5 >> 4, hl = (l5 >> 2) & 3, qd = l5 & 3;
    const float* r64 = wsp<float>(F, WS_ROPE64); bf16* P = wsp<bf16>(F, WS_PROJ1); float* KM = wsp<float>(F, WS_KMEAN);
    for (int item = F.bid; item < NB * MOBA_NB * 2; item += F.G) {
        const int hh = item & 1, n = (item >> 1) % MOBA_NB, b = item / (2 * MOBA_NB); const int col = 1536 + ten * 512 + (4 * hh + hl) * 64 + 8 * qd;
        float acc[16];
#pragma unroll
        for (int e = 0; e < 16; ++e) acc[e] = 0.f;
        for (int ig = 0; ig < 4; ++ig) {
            v4u w1[4], w2[4]; f32x4 tt[4][4];
#pragma unroll
            for (int u = 0; u < 4; ++u) { const int pos = n * MOBA_BLK + 32 * wave + 2 * (4 * ig + u) + par; const bf16* p = P + ((size_t)b * S + pos) * IN1P + col;
                w1[u] = *(const v4u*)p; w2[u] = *(const v4u*)(p + 32); const f32x4* tb = (const f32x4*)(r64 + ((size_t)pos * 32 + 8 * qd) * 2); tt[u][0] = tb[0]; tt[u][1] = tb[1]; tt[u][2] = tb[2]; tt[u][3] = tb[3]; }
#pragma unroll
            for (int u = 0; u < 4; ++u) { const int pos = n * MOBA_BLK + 32 * wave + 2 * (4 * ig + u) + par; bf16* p = P + ((size_t)b * S + pos) * IN1P + col;
                float o1[8], o2[8];
#pragma unroll
                for (int e = 0; e < 4; ++e) { const float a0 = bflo(w1[u][e]), a1 = bfhi(w1[u][e]), b0 = bflo(w2[u][e]), b1 = bfhi(w2[u][e]); const f32x4 cs = tt[u][e];
                    o1[2 * e] = a0 * cs.x - b0 * cs.y; o2[2 * e] = b0 * cs.x + a0 * cs.y; o1[2 * e + 1] = a1 * cs.z - b1 * cs.w; o2[2 * e + 1] = b1 * cs.z + a1 * cs.w; }
                v4u s1, s2;
#pragma unroll
                for (int e = 0; e < 4; ++e) { s1[e] = pk2(o1[2 * e], o1[2 * e + 1]); s2[e] = pk2(o2[2 * e], o2[2 * e + 1]); }
                *(v4u*)p = s1; *(v4u*)(p + 32) = s2;
#pragma unroll
                for (int e = 0; e < 8; ++e) { acc[e] += o1[e]; acc[8 + e] += o2[e]; } }
        }
        __syncthreads();
        if (ten == 1) { LAS f32x4* d = (LAS f32x4*)(L + ((wave * 2 + par) * 16 + (l5 & 15)) * 16);
#pragma unroll
            for (int e = 0; e < 4; ++e) d[e] = (f32x4){acc[4 * e], acc[4 * e + 1], acc[4 * e + 2], acc[4 * e + 3]}; }
        __syncthreads();
        if (tid < 256) { const int l4 = tid >> 4, e = tid & 15; float s = 0.f;
#pragma unroll
            for (int w = 0; w < 16; ++w) s += L[(w * 16 + l4) * 16 + e];
            const int hl2 = l4 >> 2, qd2 = l4 & 3, d = (e < 8 ? 8 * qd2 + e : 32 + 8 * qd2 + (e - 8));
            KM[(((size_t)b * NH + 4 * hh + hl2) * MOBA_NB + n) * 64 + d] = s * (1.f / 256.f); }
    }
}
__device__ __forceinline__ void logf_body(const Frame& F, int mm, const f32x4 (&v)[4], float fbias) {
    float o[8]; row_dot8(F, v, o);
    if (F.lane < 8) { float x = 0.f;
#pragma unroll
        for (int e = 0; e < 8; ++e) x = F.lane == e ? o[e] : x;
        x += fbias; const float ls = fminf(x, 0.f) - log1pf(__expf(-fabsf(x))); wsp<float>(F, WS_LOGF)[(size_t)mm * 8 + F.lane] = ls; }
}
__device__ __forceinline__ void p9_norm_logf(const Frame& F, const Args& a) {
    const int gw = F.bid * NWAVES + F.wave, NGW = F.G * NWAVES; f32x4 v[4]; float o[8];
    stage_w8(F, kin(24), IN1, 1536);
    const float fb_ = F.lane < 8 ? kin(25)[F.lane] : 0.f;
    RMS_ROWS(wsp<bf16>(F, WS_HB), kin(23), wsp<bf16>(F, WS_XNL1), logf_body(F, mm, v, fb_));
}
__device__ __forceinline__ void route_body(const Frame& F, int mm, const f32x4 (&v)[4], LAS unsigned* lcnt, int* TE, int* TP, float* TG) {
    float o[8]; row_dot8(F, v, o);
    int e0 = 0; float l0 = o[0];
#pragma unroll
    for (int e = 1; e < 8; ++e) if (o[e] > l0) { l0 = o[e]; e0 = e; }
    int e1 = -1; float l1 = -INFINITY;
#pragma unroll
    for (int e = 0; e < 8; ++e) if (e != e0 && o[e] > l1) { l1 = o[e]; e1 = e; }
    if (F.lane == 0) { const float g1 = 1.0f / (1.0f + __expf(l0 - l1)), g0 = 1.0f - g1;
        const int p0 = (int)__hip_atomic_fetch_add(lcnt + e0, 1u, __ATOMIC_RELAXED, __HIP_MEMORY_SCOPE_WORKGROUP), p1 = (int)__hip_atomic_fetch_add(lcnt + e1, 1u, __ATOMIC_RELAXED, __HIP_MEMORY_SCOPE_WORKGROUP);
        TE[2 * mm] = e0; TE[2 * mm + 1] = e1; TP[2 * mm] = p0; TP[2 * mm + 1] = p1; TG[2 * mm] = g0; TG[2 * mm + 1] = g1; }
}
__device__ __forceinline__ void p14_norm_route(const Frame& F, const Args& a) {
    const int gw = F.bid * NWAVES + F.wave, NGW = F.G * NWAVES; f32x4 v[4]; float o[8]; gu32* cnt = (gu32*)(F.ws + WS_CTL) + CW_CNT;
    LAS unsigned* lcnt = (LAS unsigned*)(F.lds + 110 * 1024);
    if (F.tid < 8) lcnt[F.tid] = 0u;
    stage_w8(F, kin(28), NE, 0);
    int* TE = wsp<int>(F, WS_TOPE); int* TP = wsp<int>(F, WS_TOPP); float* TG = wsp<float>(F, WS_TOPG);
    RMS_ROWS(wsp<bf16>(F, WS_HB), kin(27), wsp<unsigned char>(F, WS_XN2), route_body(F, mm, v, lcnt, TE, TP, TG));
    __syncthreads();
    if (F.tid < 8) wsp<int>(F, WS_TILEE)[1024 + F.bid * 8 + F.tid] = (int)__hip_atomic_fetch_add(cnt + F.tid, lcnt[F.tid], RLX_AGENT);
}
__device__ __forceinline__ void p15_gather_convert(const Frame& F, const Args& a) {
    const int gw = F.bid * NWAVES + F.wave, NGW = F.G * NWAVES, lane = F.lane; gu32* cnt = (gu32*)(F.ws + WS_CTL) + CW_CNT;
    int base[9]; base[0] = 0;
#pragma unroll
    for (int e = 0; e < 8; ++e) { const int c = (int)__hip_atomic_load(cnt + e, RLX_AGENT); base[e + 1] = base[e] + ((c + 255) >> 8) * 256; }
    int* TLE = wsp<int>(F, WS_TILEE);
    if (F.bid == 0 && F.tid < MOE_MAX_TILES) { const int rt = F.tid; int e = 0;
#pragma unroll
        for (int j = 1; j < 8; ++j) if (rt * 256 >= base[j]) e = j;
        TLE[rt] = e; if (rt == 0) TLE[512] = base[8] >> 8; }
    const int* TE = wsp<int>(F, WS_TOPE); const int* TP = wsp<int>(F, WS_TOPP); int* PR = wsp<int>(F, WS_PROW); const unsigned char* XN = wsp<unsigned char>(F, WS_XN2); unsigned char* XG = wsp<unsigned char>(F, WS_XG8);
    constexpr int GT = 8;
    for (int m0 = gw * GT; m0 < T; m0 += NGW * GT) { int rowA[GT], rowB[GT]; v4u s0[GT];
#pragma unroll
        for (int u = 0; u < GT; ++u) { const int m = m0 + u; const int e0 = TE[2 * m], e1 = TE[2 * m + 1], p0 = TP[2 * m], p1 = TP[2 * m + 1]; const int blk = (m % NGW) >> 3; int b0 = 0, b1 = 0;
#pragma unroll
            for (int j = 0; j < 8; ++j) { b0 = e0 == j ? base[j] : b0; b1 = e1 == j ? base[j] : b1; }
            rowA[u] = b0 + TLE[1024 + blk * 8 + e0] + p0; rowB[u] = b1 + TLE[1024 + blk * 8 + e1] + p1;
            s0[u] = ((const v4u*)(XN + (size_t)m * D))[lane]; }
#pragma unroll
        for (int u = 0; u < GT; ++u) { const int m = m0 + u; if (lane == 0) { PR[2 * m] = rowA[u]; PR[2 * m + 1] = rowB[u]; }
            ((v4u*)(XG + (size_t)rowA[u] * D))[lane] = s0[u]; ((v4u*)(XG + (size_t)rowB[u] * D))[lane] = s0[u]; } }
    LAS float* scr = (LAS float*)(F.lds + F.wave * 16384);
    constexpr int NIT = (D / 64) * (DE / 32), TOT = NE * 3 * NIT; static_assert(NIT == (DE / 64) * (D / 32), "tile counts");
    const int gwu = __builtin_amdgcn_readfirstlane(gw);
    f32x4 xa[8], xb[8]; const float* sa; const float* sb; unsigned char* da; unsigned char* db; int la, lb, ka, kb_; float ca, cb;
#define WC_DECODE(g_, src_, dst_, ldw_, kp_, sc_) do { const int q_ = (g_) / NIT, it_ = (g_) - q_ * NIT, e_ = q_ / 3, w_ = q_ - 3 * e_; \
        if (w_ < 2) { const int kb2 = it_ / (DE / 32), n_ = 32 * (it_ - kb2 * (DE / 32)); src_ = (w_ ? kin(30) : kin(29)) + (size_t)e_ * D * DE + (size_t)(64 * kb2) * DE + n_; ldw_ = DE; \
            dst_ = wsp<unsigned char>(F, WS_WMOE_GU) + (size_t)e_ * 2 * DE * D + (size_t)(256 * (n_ >> 7) + (n_ & 127) + 128 * w_) * D + 64 * kb2; kp_ = D; sc_ = F8_SW1; } \
        else { const int kb2 = it_ / (D / 32), n_ = 32 * (it_ - kb2 * (D / 32)); src_ = kin(31) + (size_t)e_ * DE * D + (size_t)(64 * kb2) * D + n_; ldw_ = D; \
            dst_ = wsp<unsigned char>(F, WS_WMOE_D) + (size_t)e_ * D * DE + (size_t)n_ * DE + 64 * kb2; kp_ = DE; sc_ = F8_SW2; } } while (0)
#define WC_LOAD(x_, src_, ldw_) do { _Pragma("unroll") for (int i = 0; i < 8; ++i) { const int kk = 8 * i + (lane >> 3), n4 = (lane & 7) * 4; x_[i] = __builtin_nontemporal_load((const f32x4*)(src_ + (size_t)kk * ldw_ + n4)); } } while (0)
#define WC_PIN(x_) asm volatile("" :: "v"(x_[0]), "v"(x_[1]), "v"(x_[2]), "v"(x_[3]), "v"(x_[4]), "v"(x_[5]), "v"(x_[6]), "v"(x_[7]))
#define WC_CONV(x_, dst_, kp_, sc_) do { _Pragma("unroll") for (int i = 0; i < 8; ++i) { const int kk = 8 * i + (lane >> 3), n4 = (lane & 7) * 4; LAS float* d = scr + kk * 33 + n4; \
            d[0] = x_[i].x * sc_; d[1] = x_[i].y * sc_; d[2] = x_[i].z * sc_; d[3] = x_[i].w * sc_; } \
        LDS_WAIT(); asm volatile("" ::: "memory"); const int c = lane & 3; \
        _Pragma("unroll") for (int j = 0; j < 2; ++j) { const int n = (lane >> 2) + 16 * j; const LAS float* s = scr + (16 * c) * 33 + n; \
            v4u o; o.x = pg8::pk4_fp8(s[0 * 33], s[1 * 33], s[2 * 33], s[3 * 33]); o.y = pg8::pk4_fp8(s[4 * 33], s[5 * 33], s[6 * 33], s[7 * 33]); \
            o.z = pg8::pk4_fp8(s[8 * 33], s[9 * 33], s[10 * 33], s[11 * 33]); o.w = pg8::pk4_fp8(s[12 * 33], s[13 * 33], s[14 * 33], s[15 * 33]); \
            *(v4u*)(dst_ + (size_t)n * kp_ + 16 * c) = o; } \
        LDS_WAIT(); asm volatile("" ::: "memory"); } while (0)
    int g = gwu;
    if (g < TOT) { WC_DECODE(g, sa, da, la, ka, ca); WC_LOAD(xa, sa, la); }
    for (; g < TOT; g += 2 * NGW) {
        WC_PIN(xa); if (g + NGW < TOT) { WC_DECODE(g + NGW, sb, db, lb, kb_, cb); WC_LOAD(xb, sb, lb); }
        WC_CONV(xa, da, ka, ca);
        if (g + NGW < TOT) { WC_PIN(xb); if (g + 2 * NGW < TOT) { WC_DECODE(g + 2 * NGW, sa, da, la, ka, ca); WC_LOAD(xa, sa, la); }
            WC_CONV(xb, db, kb_, cb); } }
#undef WC_DECODE
#undef WC_LOAD
#undef WC_PIN
#undef WC_CONV
}
__device__ __forceinline__ void p_final(const Frame& F, const Args& a) {
    const int gw = F.bid * NWAVES + F.wave, NGW = F.G * NWAVES, lane = F.lane;
    const int* PR = wsp<int>(F, WS_PROW); const float* TG = wsp<float>(F, WS_TOPG); const bf16* Y = wsp<bf16>(F, WS_XG); const bf16* YP = wsp<bf16>(F, WS_YP);
    constexpr int XROW0 = MOE_NPASS * MOE_PASS_TILES * 256; constexpr size_t SLAB = (size_t)MOE_XTILES * 256 * D;
    f32x4 gfin[4];
#pragma unroll
    for (int j = 0; j < 4; ++j) gfin[j] = ((const f32x4*)kin(32))[lane + 64 * j];
    if (NGW * 16 == T) {
        const int gwu = __builtin_amdgcn_readfirstlane(gw); const bf16* HBp = wsp<bf16>(F, WS_HB);
        int r0[16], r1[16]; float g0[16], g1[16];
#pragma unroll
        for (int i = 0; i < 16; ++i) { const int m = gwu + i * NGW; r0[i] = PR[2 * m]; r1[i] = PR[2 * m + 1]; g0[i] = TG[2 * m]; g1[i] = TG[2 * m + 1]; }
        v2u hA[4], yA0[4], yA1[4], hB[4], yB0[4], yB1[4];
#define FIN_LOAD(i, h, y0, y1) do { const int m_ = gwu + (i) * NGW; const v2u* hp_ = (const v2u*)(HBp + (size_t)m_ * D) + lane; \
            const v2u* p0_ = (const v2u*)(Y + (size_t)(r0[i] < XROW0 ? r0[i] : 0) * D) + lane; const v2u* p1_ = (const v2u*)(Y + (size_t)(r1[i] < XROW0 ? r1[i] : 0) * D) + lane; \
            _Pragma("unroll") for (int j = 0; j < 4; ++j) h[j] = hp_[64 * j]; _Pragma("unroll") for (int j = 0; j < 4; ++j) y0[j] = p0_[64 * j]; _Pragma("unroll") for (int j = 0; j < 4; ++j) y1[j] = p1_[64 * j]; } while (0)
#define FIN_PROC(i, h, y0, y1) do { const int m_ = gwu + (i) * NGW; f32x4 v[4]; float s = 0.f; f32x4* hr = (f32x4*)(F.H + (size_t)m_ * D) + lane; \
            _Pragma("unroll") for (int j = 0; j < 4; ++j) v[j] = (f32x4){bflo(h[j].x), bfhi(h[j].x), bflo(h[j].y), bfhi(h[j].y)}; \
            _Pragma("unroll") for (int e = 0; e < 2; ++e) { const int r = e ? r1[i] : r0[i]; const float g = e ? g1[i] : g0[i]; \
                if (r < XROW0) { _Pragma("unroll") for (int j = 0; j < 4; ++j) { const v2u a0 = e ? y1[j] : y0[j]; v[j].x += g * bflo(a0.x); v[j].y += g * bfhi(a0.x); v[j].z += g * bflo(a0.y); v[j].w += g * bfhi(a0.y); } } \
                else { f32x4 acc[4]; _Pragma("unroll") for (int j = 0; j < 4; ++j) acc[j] = (f32x4){0.f, 0.f, 0.f, 0.f}; \
                    for (int sl = 0; sl < MOE_KSPLIT; ++sl) { const v2u* y = (const v2u*)(YP + (size_t)sl * SLAB + (size_t)(r - XROW0) * D) + lane; \
                        _Pragma("unroll") for (int j = 0; j < 4; ++j) { const v2u a0 = y[64 * j]; acc[j].x += bflo(a0.x); acc[j].y += bfhi(a0.x); acc[j].z += bflo(a0.y); acc[j].w += bfhi(a0.y); } } \
                    _Pragma("unroll") for (int j = 0; j < 4; ++j) v[j] += acc[j] * g; } } \
            _Pragma("unroll") for (int j = 0; j < 4; ++j) s += (v[j].x * v[j].x + v[j].y * v[j].y) + (v[j].z * v[j].z + v[j].w * v[j].w); \
            const float rstd = 1.0f / sqrtf(wave_sum(s) * (1.f / D) + NORM_EPS); \
            _Pragma("unroll") for (int j = 0; j < 4; ++j) __builtin_nontemporal_store(v[j] * rstd * gfin[j], hr + 64 * j); } while (0)
        FIN_LOAD(0, hA, yA0, yA1);
#pragma unroll
        for (int i = 0; i < 16; i += 2) { FIN_LOAD(i + 1, hB, yB0, yB1); FIN_PROC(i, hA, yA0, yA1); if (i + 2 < 16) FIN_LOAD(i + 2, hA, yA0, yA1); FIN_PROC(i + 1, hB, yB0, yB1); }
#undef FIN_LOAD
#undef FIN_PROC
        return; }
    for (int m = gw; m < T; m += NGW) {
        const int r0 = PR[2 * m], r1 = PR[2 * m + 1]; const float g0 = TG[2 * m], g1 = TG[2 * m + 1];
        f32x4 v[4]; float s = 0.f; f32x4* hr = (f32x4*)(F.H + (size_t)m * D) + lane;
        rms_load(F, wsp<bf16>(F, WS_HB) + (size_t)m * D, v);
#pragma unroll
        for (int e = 0; e < 2; ++e) { const int r = e ? r1 : r0; const float g = e ? g1 : g0;
            if (r < XROW0) { const v2u* y = (const v2u*)(Y + (size_t)r * D) + lane;
#pragma unroll
                for (int j = 0; j < 4; ++j) { const v2u a0 = y[64 * j]; v[j].x += g * bflo(a0.x); v[j].y += g * bfhi(a0.x); v[j].z += g * bflo(a0.y); v[j].w += g * bfhi(a0.y); } }
            else { f32x4 acc[4];
#pragma unroll
                for (int j = 0; j < 4; ++j) acc[j] = (f32x4){0.f, 0.f, 0.f, 0.f};
                for (int sl = 0; sl < MOE_KSPLIT; ++sl) { const v2u* y = (const v2u*)(YP + (size_t)sl * SLAB + (size_t)(r - XROW0) * D) + lane;
#pragma unroll
                    for (int j = 0; j < 4; ++j) { const v2u a0 = y[64 * j]; acc[j].x += bflo(a0.x); acc[j].y += bfhi(a0.x); acc[j].z += bflo(a0.y); acc[j].w += bfhi(a0.y); } }
#pragma unroll
                for (int j = 0; j < 4; ++j) v[j] += acc[j] * g; } }
#pragma unroll
        for (int j = 0; j < 4; ++j) s += (v[j].x * v[j].x + v[j].y * v[j].y) + (v[j].z * v[j].z + v[j].w * v[j].w);
        const float rstd = 1.0f / sqrtf(wave_sum(s) * (1.f / D) + NORM_EPS);
#pragma unroll
        for (int j = 0; j < 4; ++j) __builtin_nontemporal_store(v[j] * rstd * gfin[j], hr + 64 * j);
    }
}
__device__ __forceinline__ void p_norm(const Frame& F, const float* gain) {
    const int gw = F.bid * NWAVES + F.wave, NGW = F.G * NWAVES; f32x4 v[4];
    RMS_ROWS(wsp<bf16>(F, WS_HB), gain, wsp<bf16>(F, WS_XNF), (void)mm);
}

constexpr int N_PHASES = 26;
__global__ void __launch_bounds__(NTHR, 2) hybrid_fwd(Args args) {
    extern __shared__ __attribute__((aligned(16))) unsigned char lds[];
    Frame F; F.lds = (LAS unsigned char*)lds; F.ws = args.ws; F.H = args.out;
    F.tid = threadIdx.x; F.lane = F.tid & 63; F.wave = __builtin_amdgcn_readfirstlane(F.tid >> 6); F.G = gridDim.x; F.bid = blockIdx.x;
    volatile LAS unsigned* MISC = (volatile LAS unsigned*)(F.lds + MISC_OFF);
    for (int u = F.tid; u < (LDS_BYTES - LDSCTL_OFF) / 4; u += NTHR) ((LAS unsigned*)(F.lds + LDSCTL_OFF))[u] = 0u;
    __syncthreads();
    gu32* ctl = (gu32*)(args.ws + WS_CTL);
    const int lo = args.ph_lo, hi = args.ph_hi;
    XcdBarrier bar; bar.bar = (unsigned*)(ctl + CW_BAR); bar.x = 0; bar.st = nullptr;
    if (hi - lo > 1) bar = xcd_barrier_post((unsigned*)(ctl + CW_BAR), MISC + 8);
#ifndef PHMASK
#define PHMASK 0xffffffffffffffffull
#endif
#define IN(k) (((PHMASK >> ((k) < 18 ? (k) : ((k) == 26 ? 20 : 18 + ((k) & 1)))) & 1ull) && lo <= (k) && (k) < hi)
#define SEAM(k) do { if (IN(k) && IN((k) + 1)) xcd_barrier(bar); { int t_ = threadIdx.x; asm volatile("" : "+v"(t_)); F.tid = t_; F.lane = t_ & 63; } } while (0)
#ifndef PROBE_DUP
#define PROBE_DUP (-1)
#endif
#define REPS(k) ((PROBE_DUP == (k)) ? 2 : 1)
#ifndef PROBE_MASK
#define PROBE_MASK 0u
#endif
#ifndef PROBE_REPN
#define PROBE_REPN 1
#endif
#define PDUP(k, body) do { body; if ((PROBE_MASK >> (k)) & 1u) { for (int rp_ = 0; rp_ < PROBE_REPN; ++rp_) { xcd_barrier(bar); body; } } } while (0)
#define REPBAR(k) do { if (rep + 1 < REPS(k)) xcd_barrier(bar); } while (0)
    LAS unsigned char* ring = F.lds + RING_OFF;
    bf16* XN = wsp<bf16>(F, WS_XN);

    if (IN(0)) { PDUP(0, p0_prologue(F, args)); } SEAM(0);
    if (PROBE_DUP == 777 && IN(1)) { for (int k_ = 0; k_ < 20; ++k_) xcd_barrier(bar); }
    if (IN(1)) { pg8::Gemm g{XN, wsp<bf16>(F, WS_WIN0), T, IN0P, D}; pg8::StaticOrder So; So.init(T, IN0P, F.G, F.bid); pg8::EpiStore E{wsp<bf16>(F, WS_PROJ0), IN0P, 0};
        pg8::gemm_phase<pg8::EpiStore, pg8::StaticOrder, true, true>(ring, g, So, E); } SEAM(1);
    if (IN(2)) { PDUP(2, p2_prep0(F, args)); } SEAM(2);
    if (IN(3)) {
        { pg8::Gemm g{wsp<bf16>(F, WS_LIN), wsp<bf16>(F, WS_WLORA), T, 1536, 256}; pg8::StaticOrder So; So.init(T, 1536, F.G, F.bid); pg8::EpiLora E{wsp<bf16>(F, WS_EW), kin(4), kin(6)};
          pg8::gemm_phase<pg8::EpiLora, pg8::StaticOrder, true, true>(ring, g, So, E); }
        __syncthreads();
        { pg8::Gemm g{wsp<bf16>(F, WS_QN), wsp<bf16>(F, WS_WUQ), T, 768, QR}; pg8::StaticOrder So; So.init(T, 768, F.G, F.bid); pg8::EpiStore E{wsp<bf16>(F, WS_QM), 768, 0};
          pg8::gemm_phase<pg8::EpiStore, pg8::StaticOrder, true, true>(ring, g, So, E); }
        __syncthreads();
        { pg8::Gemm g{wsp<bf16>(F, WS_KVN), wsp<bf16>(F, WS_WUKV), T, 1024, KVR}; pg8::StaticOrder So; So.init(T, 1024, F.G, F.bid); pg8::EpiStore E{wsp<bf16>(F, WS_KVM), 1024, 0};
          pg8::gemm_phase<pg8::EpiStore, pg8::StaticOrder, true, true>(ring, g, So, E); }
    } SEAM(3);
    if (IN(4)) {
#ifdef SEQ_SCAN
      for (int rep = 0; rep < REPS(4); ++rep) {
        if (F.bid < SCAN_ITEMS) { rwkv_scan_item(F, args, F.bid); }
        attn_queue_phase<0, -1>(F, ctl + CW_Q0 + 256 * rep);
        REPBAR(4); }
#else
        { LAS float* kt_ = (LAS float*)(F.lds + CK_TBL); for (int i_ = F.tid; i_ < 1024; i_ += NTHR) kt_[i_] = i_ < 512 ? kin(9)[i_] : kin(10)[i_ - 512]; __syncthreads(); }
        for (int rep = 0; rep < REPS(4); ++rep) { if (rep) xcd_barrier(bar); { const int t_ = F.tid >> 3, k8_ = (F.tid & 7) * 8; CkRaw ra, rb; int it = F.bid;
            if (it < CK_ITEMS) ck_load(ra, wsp<bf16>(F, WS_RKV), wsp<bf16>(F, WS_EW), wsp<bf16>(F, WS_AA), (size_t)(it >> 10) * S + (it & 127) * 64 + t_, ((it >> 7) & 7) * 64 + k8_);
            for (; it < CK_ITEMS; it += 2 * F.G) { rwkv_chunk_prep(F, it, ra, rb, it + F.G); if (it + F.G < CK_ITEMS) rwkv_chunk_prep(F, it + F.G, rb, ra, it + 2 * F.G); } } }
#endif
    } SEAM(4);
#ifdef SEQ_SCAN
    if (IN(5)) { PDUP(5, p5_rwkv_post(F, args)); } SEAM(5);
#else
    if (IN(5)) { if (F.bid < NB * NH) { rwkv_chunk_scan(F, F.bid); if (PROBE_DUP == 105) rwkv_chunk_scan(F, F.bid); } attn_queue_phase<0, -1>(F, ctl + CW_Q0); if (PROBE_DUP == 205) { xcd_barrier(bar); attn_queue_phase<0, -1>(F, ctl + CW_Q0 + 256); } } SEAM(5);
#endif
    if (IN(6)) { pg8::Gemm g{wsp<bf16>(F, WS_YMIX), wsp<bf16>(F, WS_WOUT0), T, D, D}; pg8::StaticOrder So; So.init(T, D, F.G, F.bid); pg8::EpiResidT<false, true> E{kin(0), wsp<bf16>(F, WS_HB)};
        pg8::gemm_phase<pg8::EpiResidT<false, true>, pg8::StaticOrder, true, true>(ring, g, So, E); } SEAM(6);
    if (IN(7)) { PDUP(7, p_norm(F, kin(19))); } SEAM(7);
    if (IN(8)) for (int rep = 0; rep < REPS(8); ++rep) { if (rep) xcd_barrier(bar); pg8::Gemm g{wsp<bf16>(F, WS_XNF), wsp<bf16>(F, WS_WGU0), T, 2 * DFF, D}; pg8::StaticOrder So; So.init(T, 2 * DFF, F.G, F.bid); pg8::EpiSwiGLU E{wsp<bf16>(F, WS_HID), DFF, nullptr, 0.f};
        pg8::gemm_phase<pg8::EpiSwiGLU, pg8::StaticOrder, true, true>(ring, g, So, E); } SEAM(8);
    if (IN(9)) { pg8::Gemm g{wsp<bf16>(F, WS_HID), wsp<bf16>(F, WS_WD0), T, D, DFF}; pg8::StaticOrder So; So.init(T, D, F.G, F.bid); pg8::EpiResidT<true, true> E{wsp<bf16>(F, WS_HB), wsp<bf16>(F, WS_HB)};
        pg8::gemm_phase<pg8::EpiResidT<true, true>, pg8::StaticOrder, true, true>(ring, g, So, E); } SEAM(9);
    if (IN(10)) { PDUP(10, p9_norm_logf(F, args)); } SEAM(10);
    if (IN(11)) { pg8::Gemm g{wsp<bf16>(F, WS_XNL1), wsp<bf16>(F, WS_WIN1), T, IN1P, D}; pg8::StaticOrder So; So.init(T, IN1P, F.G, F.bid); pg8::EpiStore E{wsp<bf16>(F, WS_PROJ1), IN1P, 0};
        pg8::gemm_phase<pg8::EpiStore, pg8::StaticOrder, true, true>(ring, g, So, E); } SEAM(11);
    if (IN(12)) { p11_dcum(F); p11_knorm(F); p11_moba_rope(F); } SEAM(12);
    if (IN(13)) { p13_moba_select(F); } SEAM(13);
    if (IN(14)) { layer1_attn_phase(F, ctl + CW_Q1); xcd_barrier(bar); p14_moba_combine(F); } SEAM(14);
    if (IN(15)) { pg8::Gemm g{wsp<bf16>(F, WS_YMIX), wsp<bf16>(F, WS_WOUT1), T, D, D}; pg8::StaticOrder So; So.init(T, D, F.G, F.bid); pg8::EpiResidT<true, true> E{wsp<bf16>(F, WS_HB), wsp<bf16>(F, WS_HB)};
        pg8::gemm_phase<pg8::EpiResidT<true, true>, pg8::StaticOrder, true, true>(ring, g, So, E); } SEAM(15);
    if (IN(16)) { p14_norm_route(F, args); } SEAM(16);
    if (IN(17)) { PDUP(17, p15_gather_convert(F, args)); } SEAM(17);
#pragma unroll 1
    for (int p = 0; p < MOE_NPASS; ++p) {
        const int ph = 18 + 2 * p;
        const int* TLE = wsp<int>(F, WS_TILEE);
        int ntp = 0, nx = 0; if (IN(ph) || IN(ph + 1)) { const int nt = __builtin_amdgcn_readfirstlane(TLE[512]); ntp = nt - p * MOE_PASS_TILES; ntp = ntp < 0 ? 0 : ntp;
            if (p < MOE_NPASS - 1) { ntp = ntp > MOE_PASS_TILES ? MOE_PASS_TILES : ntp; } else { nx = ntp > MOE_PASS_TILES ? ntp - MOE_PASS_TILES : 0; ntp -= nx; } }
        if (IN(ph) && ntp > 0) for (int rep = 0; rep < ((PROBE_DUP == 18 && p == 0) ? 2 : 1); ++rep) { if (rep) xcd_barrier(bar); pg8::Gemm g{wsp<bf16>(F, WS_XG8), wsp<bf16>(F, WS_WMOE_GU), XG_ROWS, 2 * DE, D / 2};
            pg8::MoeOrderAll So{TLE, ntp + nx, 2 * DE / 256, F.G, F.bid};
            pg8::EpiSwiGLU8 E{wsp<unsigned char>(F, WS_HIDM)}; pg8::gemm_phase<pg8::EpiSwiGLU8, pg8::MoeOrderAll, true, true, true>(ring, g, So, E); }
        SEAM(ph);
        if (IN(ph + 1) && ntp > 0) { pg8::Gemm g{wsp<bf16>(F, WS_HIDM), wsp<bf16>(F, WS_WMOE_D), MOE_HID_TILES * 256, D, DE / 2};
            pg8::MoeOrderAll So{TLE, ntp, D / 256, F.G, F.bid};
            pg8::EpiStoreSc E{wsp<bf16>(F, WS_XG), 0}; pg8::gemm_phase<pg8::EpiStoreSc, pg8::MoeOrderAll, true, true, true>(ring, g, So, E);
            if (nx > 0) { __syncthreads(); pg8::Gemm g2{wsp<bf16>(F, WS_HIDM), wsp<bf16>(F, WS_WMOE_D), MOE_HID_TILES * 256, D, DE / MOE_KSPLIT / 2, DE / 2};
                pg8::MoeOrder So2{TLE, p * MOE_PASS_TILES, nx, D / 256, F.G, F.bid, true, MOE_PASS_TILES, MOE_KSPLIT, DE / MOE_KSPLIT / 2};
                pg8::EpiStoreSc E2{wsp<bf16>(F, WS_YP) - (size_t)(MOE_NPASS * MOE_PASS_TILES) * 256 * D, (size_t)MOE_XTILES * 256 * D};
                pg8::gemm_phase<pg8::EpiStoreSc, pg8::MoeOrder, true, true, true>(ring, g2, So2, E2); } }
        SEAM(ph + 1);
    }
    if (IN(26)) { p_final(F, args); }
#undef IN
#undef SEAM
}

extern "C" void kernel_launch(void* const* d_in, const int* in_sizes, int n_in, void* d_out, int out_size, void* d_ws, size_t ws_size, hipStream_t stream) {
    static int grid = 0;
    if (grid == 0) {
        if (n_in != 33 || in_sizes[0] != T * D || out_size != T * D || ws_size < WS_END) { fprintf(stderr, "kernel_launch: unexpected shapes (n_in %d, in0 %d, out %d, ws %zu); nothing launched\n", n_in, n_in > 0 ? in_sizes[0] : -1, out_size, ws_size); grid = -1; return; }
        int dev = 0, cus = 0, per_cu = 0;
        if (hipGetDevice(&dev) != hipSuccess || hipDeviceGetAttribute(&cus, hipDeviceAttributeMultiprocessorCount, dev) != hipSuccess) { grid = -1; return; }
        if (hipFuncSetAttribute((const void*)hybrid_fwd, hipFuncAttributeMaxDynamicSharedMemorySize, LDS_BYTES) != hipSuccess) { fprintf(stderr, "kernel_launch: hipFuncSetAttribute failed\n"); grid = -1; return; }
        if (hipOccupancyMaxActiveBlocksPerMultiprocessor(&per_cu, (const void*)hybrid_fwd, NTHR, LDS_BYTES) != hipSuccess || per_cu < 1) fprintf(stderr, "kernel_launch: occupancy query reports %d\n", per_cu);
        (void)hipGetLastError();
        grid = cus;
    }
    if (grid < 0) return;
    if (hipMemsetAsync((char*)d_ws + WS_CTL, 0, CTL_ZERO_BYTES, stream) != hipSuccess) return;
    Args a{};
    for (int i = 0; i < 33; ++i) a.in[i] = (const float*)d_in[i];
    a.out = (float*)d_out; a.ws = (unsigned char*)d_ws;
#if MK_N_LAUNCHES == 1
    a.ph_lo = 0; a.ph_hi = N_PHASES + 1;
    hipLaunchKernelGGL(hybrid_fwd, dim3(grid), dim3(NTHR), LDS_BYTES, stream, a);
#else
    for (int ph = 0; ph <= N_PHASES; ++ph) { a.ph_lo = ph; a.ph_hi = ph + 1; hipLaunchKernelGGL(hybrid_fwd, dim3(grid), dim3(NTHR), LDS_BYTES, stream, a); }
#endif
}
```
